# Optimizing an MI355X kernel written in HIP

```python
import math
import jax
import jax.numpy as jnp
from jax import lax
import numpy as np

D_MODEL = 2048
BATCH = 4
SEQ = 4096
DEPTH = 2

HEAD_DIM = 128
N_HEADS = D_MODEL // HEAD_DIM
N_HEADS_A = N_HEADS // 2
N_HEADS_B = N_HEADS - N_HEADS_A
DILATED_BRANCHES = ((128, 1), (512, 4), (2048, 16))
MOBA_BLOCK = 256
MOBA_TOPK = 3
MOBA_QCHUNK = 32
SB_QBLOCK = 128
REL_BUCKETS = 32
REL_MAX_DIST = 2048
D_FF = 5632
FFN_HALF = 0.5
RMS_EPS = 1e-6
N_EVEN = (DEPTH + 1) // 2
N_ODD = DEPTH // 2

kernel_name = 'hybrid_dilated_moba_stickbreaking_macaron'


def rms_norm(x, g):
    xf = x.astype(jnp.float32)
    y = xf * lax.rsqrt(jnp.mean(xf * xf, axis=-1, keepdims=True) + RMS_EPS)
    return (y * g.astype(jnp.float32)).astype(x.dtype)


def swiglu(x, w_gate, w_up, w_down):
    return (jax.nn.silu(x @ w_gate) * (x @ w_up)) @ w_down


def rel_bucket(dist):
    max_exact = REL_BUCKETS // 2
    d = jnp.maximum(dist, 0)
    df = jnp.maximum(d, 1).astype(jnp.float32)
    large = max_exact + (jnp.log(df / max_exact) / math.log(REL_MAX_DIST / max_exact)
                         * (REL_BUCKETS - max_exact)).astype(jnp.int32)
    large = jnp.minimum(large, REL_BUCKETS - 1)
    return jnp.where(d < max_exact, d, large)


def dilated_branch(q, k, v, tab, window, dilation):
    Bb, H, S, hd = q.shape
    W = window // dilation
    L = S // dilation
    nb = -(-L // W)
    Lp = nb * W

    def to_sub(t):
        t = t.reshape(Bb, H, L, dilation, hd).transpose(0, 1, 3, 2, 4)
        return jnp.pad(t, ((0, 0), (0, 0), (0, 0), (0, Lp - L), (0, 0)))

    def band(t):
        tp = jnp.pad(to_sub(t), ((0, 0), (0, 0), (0, 0), (W, 0), (0, 0))).reshape(Bb, H, dilation, nb + 1, W, hd)
        return jnp.concatenate([tp[:, :, :, :-1], tp[:, :, :, 1:]], axis=4)

    qs = to_sub(q).reshape(Bb, H, dilation, nb, W, hd)
    kb, vb = band(k), band(v)
    i = jnp.arange(W)[:, None]
    j = jnp.arange(2 * W)[None, :]
    rel = W + i - j
    blk_start = jnp.arange(nb)[:, None, None] * W
    valid = (rel >= 0) & (rel <= W) & (blk_start - W + j >= 0)
    bias = tab[:, rel_bucket(rel * dilation)]
    s = jnp.einsum('bhrnqd,bhrnkd->bhrnqk', qs, kb) * (HEAD_DIM ** -0.5) + bias[:, None, None]
    s = jnp.where(valid, s, -jnp.inf)
    m = jnp.max(s, axis=-1, keepdims=True)
    p = jnp.exp(s - m)
    den = jnp.sum(p, axis=-1)
    o = jnp.einsum('bhrnqk,bhrnkd->bhrnqd', p, vb) / den[..., None]
    lse = m[..., 0] + jnp.log(den)

    def from_sub(t, tail):
        t = t.reshape(Bb, H, dilation, Lp, *tail)[:, :, :, :L]
        return jnp.moveaxis(t, 2, 3).reshape(Bb, H, S, *tail)

    return from_sub(o, (hd,)), from_sub(lse, ())


def dilated_mixture(q, k, v, tab):
    results = [dilated_branch(q, k, v, tab, w, r) for (w, r) in DILATED_BRANCHES]
    outs = jnp.stack([o for (o, _) in results])
    lses = jnp.stack([l for (_, l) in results])
    alpha = jax.nn.softmax(lses, axis=0)
    return jnp.sum(alpha[..., None] * outs, axis=0)


def moba_attention(q, k, v, tab):
    Bb, H, S, hd = q.shape
    nblk = -(-S // MOBA_BLOCK)
    Sp = nblk * MOBA_BLOCK
    pad = ((0, 0), (0, 0), (0, Sp - S), (0, 0))
    kp, vp = jnp.pad(k, pad), jnp.pad(v, pad)
    kb = kp.reshape(Bb, H, nblk, MOBA_BLOCK, hd)
    vb = vp.reshape(Bb, H, nblk, MOBA_BLOCK, hd)
    own = jnp.arange(S) // MOBA_BLOCK
    gate = jnp.einsum('bhsd,bhnd->bhsn', q, jnp.mean(kb, axis=3))
    gate = jnp.where(jnp.arange(nblk)[None, :] < own[:, None], gate, -jnp.inf)
    n_sel = min(MOBA_TOPK, nblk)
    _, sel = lax.top_k(gate, n_sel)
    sel_ok = sel < own[:, None]
    nC = S // MOBA_QCHUNK

    def chunks(t):
        return jnp.moveaxis(t.reshape(Bb, H, nC, MOBA_QCHUNK, *t.shape[3:]), 2, 0)

    bi = jnp.arange(Bb)[:, None, None, None]
    hi = jnp.arange(H)[None, :, None, None]
    hi5 = jnp.arange(H)[None, :, None, None, None]
    offs = jnp.arange(MOBA_BLOCK)
    scale = HEAD_DIM ** -0.5

    def chunk_attn(args):
        qc, selc, okc, c = args
        qpos = c * MOBA_QCHUNK + jnp.arange(MOBA_QCHUNK)
        own_start = (c * MOBA_QCHUNK // MOBA_BLOCK) * MOBA_BLOCK
        k_sel = kb[bi, hi, selc]
        v_sel = vb[bi, hi, selc]
        k_own = lax.dynamic_slice_in_dim(kp, own_start, MOBA_BLOCK, axis=2)
        v_own = lax.dynamic_slice_in_dim(vp, own_start, MOBA_BLOCK, axis=2)
        dist_sel = qpos[:, None, None] - (selc[..., None] * MOBA_BLOCK + offs)
        s_sel = jnp.einsum('bhqd,bhqnkd->bhqnk', qc, k_sel) * scale + tab[hi5, rel_bucket(dist_sel)]
        s_sel = jnp.where(okc[..., None], s_sel, -jnp.inf)
        dist_own = qpos[:, None] - (own_start + offs)[None, :]
        s_own = jnp.einsum('bhqd,bhkd->bhqk', qc, k_own) * scale + tab[:, rel_bucket(dist_own)]
        s_own = jnp.where(dist_own >= 0, s_own, -jnp.inf)
        n_k = n_sel * MOBA_BLOCK
        p = jax.nn.softmax(jnp.concatenate([s_sel.reshape(Bb, H, MOBA_QCHUNK, n_k), s_own], axis=-1), axis=-1)
        p_sel = p[..., :n_k].reshape(Bb, H, MOBA_QCHUNK, n_sel, MOBA_BLOCK)
        return (jnp.einsum('bhqnk,bhqnkd->bhqd', p_sel, v_sel)
                + jnp.einsum('bhqk,bhkd->bhqd', p[..., n_k:], v_own))

    out = lax.map(chunk_attn, (chunks(q), chunks(sel), chunks(sel_ok), jnp.arange(nC)))
    return jnp.moveaxis(out, 0, 2).reshape(Bb, H, S, hd)


def stick_breaking_attention(q, k, v):
    Bb, H, S, hd = q.shape
    nQ = S // SB_QBLOCK
    kpos = jnp.arange(S)
    scale = HEAD_DIM ** -0.5

    def block(args):
        qc, c = args
        qpos = c * SB_QBLOCK + jnp.arange(SB_QBLOCK)
        past = kpos[None, :] < qpos[:, None]
        z = jnp.einsum('bhqd,bhkd->bhqk', qc, k) * scale
        log_keep = jnp.where(past, jax.nn.log_sigmoid(-z), 0.0)
        between = lax.cumsum(log_keep, axis=3, reverse=True) - log_keep
        log_w = jnp.where(past, jax.nn.log_sigmoid(z) + between, -jnp.inf)
        return jnp.einsum('bhqk,bhkd->bhqd', jnp.exp(log_w), v)

    qb = jnp.moveaxis(q.reshape(Bb, H, nQ, SB_QBLOCK, hd), 2, 0)
    out = lax.map(block, (qb, jnp.arange(nQ)))
    return jnp.moveaxis(out, 0, 2).reshape(Bb, H, S, hd)


def split_qkv(u, w_qkv):
    Bb, S, _ = u.shape
    qkv = (u @ w_qkv).reshape(Bb, S, 3, N_HEADS, HEAD_DIM).astype(jnp.float32)
    return [qkv[:, :, j].transpose(0, 2, 1, 3) for j in range(3)]


def merge_heads(o, w_out, dtype):
    Bb, H, S, hd = o.shape
    return o.transpose(0, 2, 1, 3).reshape(Bb, S, H * hd).astype(dtype) @ w_out


def mix_even(u, w_qkv, w_out, rel_bias):
    q, k, v = split_qkv(u, w_qkv)
    tab = rel_bias.astype(jnp.float32).T
    a = slice(0, N_HEADS_A)
    b = slice(N_HEADS_A, N_HEADS)
    o_a = dilated_mixture(q[:, a], k[:, a], v[:, a], tab[a])
    o_b = moba_attention(q[:, b], k[:, b], v[:, b], tab[b])
    return merge_heads(jnp.concatenate([o_a, o_b], axis=1), w_out, u.dtype)


def mix_odd(u, w_qkv, w_out):
    q, k, v = split_qkv(u, w_qkv)
    return merge_heads(stick_breaking_attention(q, k, v), w_out, u.dtype)


def setup_inputs(seed: int = 0) -> dict:
    key = jax.random.key(seed)
    ks = jax.random.split(key, 12)
    D = D_MODEL
    nrm = jax.random.normal
    x = nrm(ks[0], (BATCH, SEQ, D), jnp.float32)
    ln_gains = 1.0 + 0.02 * nrm(ks[1], (DEPTH, 3, D), jnp.float32)
    ffn_w_gate = nrm(ks[2], (DEPTH, 2, D, D_FF), jnp.float32) * D ** -0.5
    ffn_w_up = nrm(ks[3], (DEPTH, 2, D, D_FF), jnp.float32) * D ** -0.5
    ffn_w_down = nrm(ks[4], (DEPTH, 2, D_FF, D), jnp.float32) * D_FF ** -0.5
    w_qkv_even = nrm(ks[5], (N_EVEN, D, 3 * D), jnp.float32) * D ** -0.5
    w_out_even = nrm(ks[6], (N_EVEN, D, D), jnp.float32) * D ** -0.5
    w_qkv_odd = nrm(ks[7], (N_ODD, D, 3 * D), jnp.float32) * D ** -0.5
    w_out_odd = nrm(ks[8], (N_ODD, D, D), jnp.float32) * D ** -0.5
    rel_bias = 0.5 * nrm(ks[9], (REL_BUCKETS, N_HEADS), jnp.float32)
    final_gain = 1.0 + 0.02 * nrm(ks[10], (D,), jnp.float32)
    return {'x': x, 'ln_gains': ln_gains, 'ffn_w_gate': ffn_w_gate, 'ffn_w_up': ffn_w_up,
            'ffn_w_down': ffn_w_down, 'w_qkv_even': w_qkv_even, 'w_out_even': w_out_even,
            'w_qkv_odd': w_qkv_odd, 'w_out_odd': w_out_odd, 'rel_bias': rel_bias,
            'final_gain': final_gain}


def reference(x, ln_gains, ffn_w_gate, ffn_w_up, ffn_w_down, w_qkv_even, w_out_even,
              w_qkv_odd, w_out_odd, rel_bias, final_gain):
    h = x
    for i in range(DEPTH):
        h = h + FFN_HALF * swiglu(rms_norm(h, ln_gains[i, 0]), ffn_w_gate[i, 0], ffn_w_up[i, 0], ffn_w_down[i, 0])
        u = rms_norm(h, ln_gains[i, 1])
        if i % 2 == 0:
            h = h + mix_even(u, w_qkv_even[i // 2], w_out_even[i // 2], rel_bias)
        else:
            h = h + mix_odd(u, w_qkv_odd[i // 2], w_out_odd[i // 2])
        h = h + FFN_HALF * swiglu(rms_norm(h, ln_gains[i, 2]), ffn_w_gate[i, 1], ffn_w_up[i, 1], ffn_w_down[i, 1])
    return rms_norm(h, final_gain)
```

```cpp
#include <hip/hip_runtime.h>
#include <hip/hip_cooperative_groups.h>
#include <cstdio>
#include <cstdint>
namespace cg = cooperative_groups;
namespace pg8 {
#define PG8_LAS __attribute__((address_space(3)))
extern __shared__ __attribute__((aligned(16))) unsigned char lds_raw[];
__device__ __forceinline__ int lane_id() { return (int)__builtin_amdgcn_mbcnt_hi(~0u, __builtin_amdgcn_mbcnt_lo(~0u, 0u)); }
typedef unsigned short bf16_t;
typedef short bf16x8 __attribute__((ext_vector_type(8)));
typedef float f32x4 __attribute__((ext_vector_type(4)));
typedef unsigned u32x4 __attribute__((ext_vector_type(4)));
constexpr int BM = 256, BK = 64, HALF = 128, HTB = HALF * BK * 2  , STAGE_BYTES = 8 * HTB, NXCD = 8, WGM = 8;

__host__ __device__ __forceinline__ int lds_byte(int r, int c) { const int st = (r >> 4) * 2 + (c >> 5), rr = r & 15, cc = c & 31, ob = rr * 64 + cc * 2; return st * 1024 + (ob ^ (((ob >> 9) & 1) << 5)); }
__host__ __device__ __forceinline__ void stage_rc(int b, int& R, int& C) { const int st = b / 1024, sb = b % 1024, swz = sb ^ (((sb >> 9) & 1) << 5); R = (st >> 1) * 16 + swz / 64; C = (st & 1) * 32 + (swz % 64) / 2; }
__host__ __device__ __forceinline__ int perm32(int rho) { const int n = rho >> 4, i = rho & 15; return 8 * (i >> 2) + 4 * n + (i & 3); }

struct Unit { int pm, pn; };
struct Gemm { const bf16_t* A; const bf16_t* Bt; int M, N, K; };

struct StaticOrder {
    int nM, nN, nwg, G, c;
    __host__ __device__ void init(int M, int N, int G_, int c_) { nM = M / BM; nN = N / BM; nwg = nM * nN; G = G_; c = c_; }
    __host__ __device__ bool next(int i, Unit& u) const {
        const long L = (long)i * G + c; if (L >= nwg) return false;
        int wgid = (int)L; { const int q = nwg / NXCD, r = nwg % NXCD, xcd = wgid % NXCD, off = wgid / NXCD; wgid = (xcd < r ? xcd * (q + 1) : r * (q + 1) + (xcd - r) * q) + off; }
        const int nig = WGM * nN, gid = wgid / nig, fm = gid * WGM, gsz = (nM - fm) < WGM ? (nM - fm) : WGM;
        u.pm = fm + ((wgid % nig) % gsz); u.pn = (wgid % nig) / gsz; return true;
    }
    __device__ __forceinline__ void a_ready(const Unit&) const {}
    __device__ __forceinline__ void done(const Unit&) const {}
};

__device__ __forceinline__ unsigned cvt_pk_bf16(float lo, float hi) { unsigned r; asm volatile("v_cvt_pk_bf16_f32 %0, %1, %2" : "=v"(r) : "v"(lo), "v"(hi)); return r; }
typedef float f32x2 __attribute__((ext_vector_type(2)));
__device__ __forceinline__ f32x2 gelu_pk(f32x2 v) {
    const f32x2 av = __builtin_elementwise_abs(v), d = av * 0.2316418882f + 1.0f;
    f32x2 t; t.x = __builtin_amdgcn_rcpf(d.x); t.y = __builtin_amdgcn_rcpf(d.y);
    f32x2 q = t * 0.5307027145f + (-0.7265760135f); q = q * t + 0.7107068705f; q = q * t + (-0.142248368f); q = q * t + 0.127414796f; q = q * t;
    const f32x2 s = (v * v) * (-0.72134752044f);
    f32x2 e; e.x = __builtin_amdgcn_exp2f(s.x); e.y = __builtin_amdgcn_exp2f(s.y);
    const f32x2 m = v * (q * e), r = v - m;
    f32x2 o; o.x = v.x < 0.f ? m.x : r.x; o.y = v.y < 0.f ? m.y : r.y; return o;
}

template <int ACT  > struct EpiBf16 {
    static constexpr bool PERM = true, AFTER_DRAIN = false; static_assert(ACT == 0 || ACT == 1, "EpiBf16: ACT is 0 (none) or 1 (gelu_pk)");
    bf16_t* O; int ldc; const float* bias; int split_cols; size_t split_stride; float scale0;
    __device__ __forceinline__ void operator()(const f32x4 (&acc)[2][2][4][2], const Unit& u, int wr, int wc, int fr, int fq) const {
        const int row0 = u.pm * BM + wr * 64 + fr; int colt = u.pn * BM; bf16_t* base = O;
        float sc = 1.f; if (split_cols) { const int t = colt / split_cols; base += (size_t)t * split_stride; colt -= t * split_cols; if (t == 0) sc = scale0; }
        const int col0 = colt + wc * 32 + 8 * fq, bcol0 = u.pn * BM + wc * 32 + 8 * fq;
        f32x4 bv[2][2];
#pragma unroll
        for (int bj = 0; bj < 2; ++bj)
#pragma unroll
            for (int n = 0; n < 2; ++n) bv[bj][n] = bias ? *(const f32x4*)(bias + bcol0 + bj * HALF + 4 * n) : (f32x4){0.f, 0.f, 0.f, 0.f};
#pragma unroll
        for (int ai = 0; ai < 2; ++ai)
#pragma unroll
            for (int m = 0; m < 4; ++m) { bf16_t* rowp = base + (size_t)(row0 + ai * HALF + m * 16) * ldc + col0;
#pragma unroll
                for (int bj = 0; bj < 2; ++bj) { f32x4 v0 = acc[ai][bj][m][0] + bv[bj][0], v1 = acc[ai][bj][m][1] + bv[bj][1];
                    if (ACT == 1) { f32x2 a = gelu_pk((f32x2){v0[0], v0[1]}), b = gelu_pk((f32x2){v0[2], v0[3]}), c = gelu_pk((f32x2){v1[0], v1[1]}), d = gelu_pk((f32x2){v1[2], v1[3]});
                        v0 = (f32x4){a.x, a.y, b.x, b.y}; v1 = (f32x4){c.x, c.y, d.x, d.y}; }
                    v0 = v0 * sc; v1 = v1 * sc; u32x4 w; w.x = cvt_pk_bf16(v0[0], v0[1]); w.y = cvt_pk_bf16(v0[2], v0[3]); w.z = cvt_pk_bf16(v1[0], v1[1]); w.w = cvt_pk_bf16(v1[2], v1[3]);
                    *(u32x4*)(rowp + bj * HALF) = w; } }
    }
};
__device__ __forceinline__ void load_rstd8_lds(const PG8_LAS float* rt, int rloc, float (&rs)[2][4]) {
#pragma unroll
    for (int ai = 0; ai < 2; ++ai)
#pragma unroll
        for (int m = 0; m < 4; ++m) rs[ai][m] = rt[rloc + ai * HALF + m * 16];
}
__device__ __forceinline__ void load_rstd8(const float* ss, int row0, float (&rs)[2][4]) {
    float v[2][4];
#pragma unroll
    for (int ai = 0; ai < 2; ++ai)
#pragma unroll
        for (int m = 0; m < 4; ++m) v[ai][m] = ss[row0 + ai * HALF + m * 16];
#pragma unroll
    for (int ai = 0; ai < 2; ++ai)
#pragma unroll
        for (int m = 0; m < 4; ++m) rs[ai][m] = __builtin_amdgcn_rsqf(v[ai][m] * (1.0f / 2048.0f) + 1e-6f);
}
struct EpiSwiglu {
    static constexpr bool PERM = true, AFTER_DRAIN = false;
    bf16_t* O; int ldc; const float* ss; int pm0;
    __device__ __forceinline__ void operator()(const f32x4 (&acc)[2][2][4][2], const Unit& u, int wr, int wc, int fr, int fq) const {
        const int row0 = u.pm * BM + wr * 64 + fr, col0 = u.pn * HALF + wc * 32 + 8 * fq;
        float rsv[2][4]; load_rstd8_lds((const PG8_LAS float*)((PG8_LAS unsigned char*)lds_raw + 155712), wr * 64 + fr, rsv);
#pragma unroll
        for (int ai = 0; ai < 2; ++ai)
#pragma unroll
            for (int m = 0; m < 4; ++m) {
                const int row = row0 + ai * HALF + m * 16; bf16_t* rowp = O + (size_t)row * ldc + col0;
                const float rs = rsv[ai][m];
                float r[8];
#pragma unroll
                for (int n = 0; n < 2; ++n)
#pragma unroll
                    for (int e = 0; e < 4; ++e) { const float g = acc[ai][0][m][n][e] * rs, up = acc[ai][1][m][n][e] * rs;
                        const float sg = g * __builtin_amdgcn_rcpf(1.0f + __builtin_amdgcn_exp2f(-1.44269504089f * g)); r[4 * n + e] = sg * up; }
                u32x4 w; w.x = cvt_pk_bf16(r[0], r[1]); w.y = cvt_pk_bf16(r[2], r[3]); w.z = cvt_pk_bf16(r[4], r[5]); w.w = cvt_pk_bf16(r[6], r[7]);
                *(u32x4*)rowp = w; }
    }
};
struct EpiResid {
    static constexpr bool PERM = true, AFTER_DRAIN = false;
    bf16_t* hi; float* ss; int ldc; float scale;
    __device__ __forceinline__ void operator()(const f32x4 (&acc)[2][2][4][2], const Unit& u, int wr, int wc, int fr, int fq) const {
        const int row0 = u.pm * BM + wr * 64 + fr, col0 = u.pn * BM + wc * 32 + 8 * fq;
#pragma unroll
        for (int ai = 0; ai < 2; ++ai)
#pragma unroll
            for (int m = 0; m < 4; ++m) { const int row = row0 + ai * HALF + m * 16; const size_t off = (size_t)row * ldc + col0; float q = 0.f;
#pragma unroll
                for (int bj = 0; bj < 2; ++bj) { const size_t ix = off + bj * HALF;
                    const u32x4 xh = *(const u32x4*)(hi + ix);
                    u32x4 wh;
#pragma unroll
                    for (int e = 0; e < 4; ++e) {
                        const float a = acc[ai][bj][m][e >> 1][2 * (e & 1)], b = acc[ai][bj][m][e >> 1][2 * (e & 1) + 1];
                        const float o0 = __uint_as_float(xh[e] << 16) + a * scale, o1 = __uint_as_float(xh[e] & 0xffff0000u) + b * scale;
                        const unsigned h2 = cvt_pk_bf16(o0, o1); wh[e] = h2;
                        const float r0 = __uint_as_float(h2 << 16), r1 = __uint_as_float(h2 & 0xffff0000u);
                        q += r0 * r0 + r1 * r1; }
                    *(u32x4*)(hi + ix) = wh; }
                q += __shfl_xor(q, 16); q += __shfl_xor(q, 32);
                if (fq == 0) ss[(size_t)row * 32 + u.pn * 4 + wc] = q;
                }
    }
};
struct EpiQkv {
    static constexpr bool PERM = true, AFTER_DRAIN = false;
    bf16_t* O; int ldc; const float* ss; int pm0; bf16_t* KT; int kt_lo;
    __device__ __forceinline__ void operator()(const f32x4 (&acc)[2][2][4][2], const Unit& u, int wr, int wc, int fr, int fq) const {
        const int row0 = u.pm * BM + wr * 64 + fr, col0 = u.pn * BM + wc * 32 + 8 * fq;
        float rsv[2][4]; load_rstd8_lds((const PG8_LAS float*)((PG8_LAS unsigned char*)lds_raw + 155712), wr * 64 + fr, rsv);
        if (u.pn >= kt_lo && u.pn < 16) {
#pragma unroll
            for (int ai = 0; ai < 2; ++ai)
#pragma unroll
                for (int m = 0; m < 4; ++m) { const int row = row0 + ai * HALF + m * 16;
                    const float rs = rsv[ai][m];
                    const int b = row >> 12, key = row & 4095;
#pragma unroll
                    for (int bj = 0; bj < 2; ++bj) { const int head = (u.pn - 8) * 2 + bj;
                        bf16_t* p = KT + ((size_t)((b * 16 + head) * 128 + (key >> 5)) << 12) + (wc * 2 + (fq >> 1)) * 512 + ((fq & 1) * 32 + (key & 31)) * 8;
                        const f32x4 v0 = acc[ai][bj][m][0] * rs, v1 = acc[ai][bj][m][1] * rs;
                        u32x4 w; w.x = cvt_pk_bf16(v0[0], v0[1]); w.y = cvt_pk_bf16(v0[2], v0[3]); w.z = cvt_pk_bf16(v1[0], v1[1]); w.w = cvt_pk_bf16(v1[2], v1[3]);
                        *(u32x4*)p = w; } }
            return; }
#pragma unroll
        for (int ai = 0; ai < 2; ++ai)
#pragma unroll
            for (int m = 0; m < 4; ++m) { const int row = row0 + ai * HALF + m * 16;
                const float rs = rsv[ai][m];
                bf16_t* rowp = O + (size_t)row * ldc + col0;
#pragma unroll
                for (int bj = 0; bj < 2; ++bj) { const f32x4 v0 = acc[ai][bj][m][0] * rs, v1 = acc[ai][bj][m][1] * rs;
                    u32x4 w; w.x = cvt_pk_bf16(v0[0], v0[1]); w.y = cvt_pk_bf16(v0[2], v0[3]); w.z = cvt_pk_bf16(v1[0], v1[1]); w.w = cvt_pk_bf16(v1[2], v1[3]);
                    *(u32x4*)(rowp + bj * HALF) = w; } }
    }
};
template <class Epi, class Sched, bool ALIGN_EPI = false, bool SP2 = false>
__device__ __forceinline__ void gemm_phase(PG8_LAS unsigned char* lds, const Gemm g, const Sched& S, const Epi& E, int wave_s  ) {
    int tid_ = wave_s * 64 + lane_id(); asm volatile("" : "+v"(tid_));
    const int tid = tid_, wid = __builtin_amdgcn_readfirstlane(tid >> 6), lane = tid & 63, wr = wid >> 2, wc = wid & 3, fr = lane & 15, fq = lane >> 4;
    const int K = g.K, nt = K / BK;
    unsigned voffA[2], voffB[2];
#pragma unroll
    for (int i = 0; i < 2; ++i) { int R, C; stage_rc(tid * 16 + i * 8192, R, C); const int Rb = Epi::PERM ? ((R & ~31) + perm32(R & 31)) : R;
        voffA[i] = (unsigned)(R * K + C) * 2u; voffB[i] = (unsigned)(Rb * K + C) * 2u; }
    const size_t kstep = (size_t)(BK * 2);
    const size_t hstep = (size_t)HALF * K * 2;
    const size_t tstep = 2 * hstep;
    const unsigned ldsw = (unsigned)wid * 1024u;
    const int aoff = lds_byte(wr * 64 + fr, fq * 8), boff = lds_byte(wc * 32 + fr, fq * 8);
#define PG8_SA(b, h) (((b) * 2 + (h)) * HTB)
#define PG8_SB(b, h) ((4 + (b) * 2 + (h)) * HTB)
#define PG8_STAGE(bufoff, gbase, voff) do { _Pragma("unroll") for (int _i = 0; _i < 2; ++_i) \
        __builtin_amdgcn_global_load_lds((const unsigned*)((const char*)(gbase) + (voff)[_i]), (PG8_LAS unsigned*)(lds + (bufoff) + ldsw + _i * 8192), 16, 0, 0); } while (0)
#define PG8_LDA(dst, b, h) do { _Pragma("unroll") for (int m = 0; m < 4; ++m) _Pragma("unroll") for (int k = 0; k < 2; ++k) dst[m][k] = *(const PG8_LAS bf16x8*)(lds + PG8_SA(b, h) + aoff + m * 2048 + k * 1024); } while (0)
#define PG8_LDB(dst, b, h) do { _Pragma("unroll") for (int n = 0; n < 2; ++n) _Pragma("unroll") for (int k = 0; k < 2; ++k) dst[n][k] = *(const PG8_LAS bf16x8*)(lds + PG8_SB(b, h) + boff + n * 2048 + k * 1024); } while (0)
#define PG8_MMA(ai, bj, At, Bt) do { __builtin_amdgcn_s_setprio(1); _Pragma("unroll") for (int m = 0; m < 4; ++m) _Pragma("unroll") for (int n = 0; n < 2; ++n) _Pragma("unroll") for (int k = 0; k < 2; ++k) \
        acc[ai][bj][m][n] = __builtin_amdgcn_mfma_f32_16x16x32_bf16(Bt[n][k], At[m][k], acc[ai][bj][m][n], 0, 0, 0); __builtin_amdgcn_s_setprio(0); } while (0)
#define PG8_WAIT_V(n) asm volatile("s_waitcnt vmcnt(" #n ")" ::: "memory")
#define PG8_WAIT_L(n) asm volatile("s_waitcnt lgkmcnt(" #n ")" ::: "memory")
#define PG8_BAR __builtin_amdgcn_s_barrier()
#define PG8_SCHED __builtin_amdgcn_sched_barrier(0)
    Unit cur, nxt; int ui = 0;
    if (!S.next(0, cur)) return;
    f32x4 acc[2][2][4][2];
#pragma unroll
    for (int a = 0; a < 2; ++a)
#pragma unroll
        for (int b = 0; b < 2; ++b)
#pragma unroll
            for (int m = 0; m < 4; ++m)
#pragma unroll
                for (int n = 0; n < 2; ++n) acc[a][b][m][n] = (f32x4){0.f, 0.f, 0.f, 0.f};
    bf16x8 At[4][2], B0[2][2], B1[2][2];
    const char* cA = (const char*)g.A + (size_t)cur.pm * tstep; const char* cB = (const char*)g.Bt + (size_t)cur.pn * tstep;
    S.a_ready(cur);
    if constexpr (SP2) {
        PG8_STAGE(PG8_SB(0, 0), cB, voffB); PG8_STAGE(PG8_SB(0, 1), cB + hstep, voffB); PG8_STAGE(PG8_SA(0, 0), cA, voffA); PG8_STAGE(PG8_SA(0, 1), cA + hstep, voffA);
        if (wr == 1) PG8_BAR;
        PG8_WAIT_V(2); PG8_BAR;
        PG8_STAGE(PG8_SB(1, 0), cB + kstep, voffB); PG8_STAGE(PG8_SA(1, 0), cA + kstep, voffA); PG8_STAGE(PG8_SB(1, 1), cB + hstep + kstep, voffB);
        PG8_WAIT_V(6); PG8_BAR;
    } else {
        PG8_STAGE(PG8_SB(0, 0), cB, voffB); PG8_STAGE(PG8_SA(0, 0), cA, voffA); PG8_STAGE(PG8_SB(0, 1), cB + hstep, voffB); PG8_STAGE(PG8_SA(0, 1), cA + hstep, voffA);
        if (wr == 1) PG8_BAR;
        PG8_WAIT_V(4); PG8_BAR;
        PG8_STAGE(PG8_SB(1, 0), cB + kstep, voffB); PG8_STAGE(PG8_SA(1, 0), cA + kstep, voffA); PG8_STAGE(PG8_SB(1, 1), cB + hstep + kstep, voffB);
        PG8_WAIT_V(6); PG8_BAR;
    }
    for (;;) {
        const bool has_next = S.next(ui + 1, nxt);
        const char* nA = has_next ? (const char*)g.A + (size_t)nxt.pm * tstep : cA; const char* nB = has_next ? (const char*)g.Bt + (size_t)nxt.pn * tstep : cB;
        for (int t = 0; t < nt; t += 2) {
            const bool last = (t == nt - 2);
            const char* a1 = cA + (size_t)(t + 1) * kstep;
            const char* a2 = last ? nA : cA + (size_t)(t + 2) * kstep; const char* b2 = last ? nB : cB + (size_t)(t + 2) * kstep;
            const char* a3 = a2 + kstep; const char* b3 = b2 + kstep;
            if (last && has_next) S.a_ready(nxt);
            if constexpr (SP2) {
            PG8_LDB(B0, 0, 0); PG8_LDB(B1, 0, 1); PG8_SCHED; PG8_LDA(At, 0, 0); PG8_STAGE(PG8_SA(1, 1), a1 + hstep, voffA);
            PG8_WAIT_V(8); PG8_WAIT_L(0); PG8_BAR; PG8_MMA(0, 0, At, B0); PG8_MMA(0, 1, At, B1); PG8_BAR; PG8_SCHED;
            PG8_LDA(At, 0, 1); PG8_STAGE(PG8_SB(0, 0), b2, voffB); PG8_STAGE(PG8_SB(0, 1), b2 + hstep, voffB); PG8_STAGE(PG8_SA(0, 0), a2, voffA);
            PG8_WAIT_V(8); PG8_WAIT_L(0); PG8_BAR; PG8_MMA(1, 0, At, B0); PG8_MMA(1, 1, At, B1); PG8_BAR; PG8_SCHED;
            PG8_LDB(B0, 1, 0); PG8_LDB(B1, 1, 1); PG8_SCHED; PG8_LDA(At, 1, 0); PG8_STAGE(PG8_SA(0, 1), a2 + hstep, voffA);
            PG8_WAIT_V(8); PG8_WAIT_L(0); PG8_BAR; PG8_MMA(0, 0, At, B0); PG8_MMA(0, 1, At, B1); PG8_BAR; PG8_SCHED;
            PG8_LDA(At, 1, 1); PG8_STAGE(PG8_SB(1, 0), b3, voffB); PG8_STAGE(PG8_SB(1, 1), b3 + hstep, voffB); PG8_STAGE(PG8_SA(1, 0), a3, voffA);
            PG8_WAIT_V(8); PG8_WAIT_L(0); PG8_BAR; PG8_MMA(1, 0, At, B0); PG8_MMA(1, 1, At, B1); PG8_BAR; PG8_SCHED;
            } else {
            PG8_LDB(B0, 0, 0); PG8_SCHED; PG8_LDA(At, 0, 0); PG8_STAGE(PG8_SA(1, 1), a1 + hstep, voffA);
            PG8_WAIT_L(8); PG8_BAR; PG8_WAIT_L(0); PG8_MMA(0, 0, At, B0); PG8_BAR; PG8_SCHED;
            PG8_LDB(B1, 0, 1); PG8_STAGE(PG8_SB(0, 0), b2, voffB);
            PG8_BAR; PG8_WAIT_L(0); PG8_MMA(0, 1, At, B1); PG8_BAR;
            PG8_LDA(At, 0, 1); PG8_STAGE(PG8_SA(0, 0), a2, voffA);
            PG8_BAR; PG8_WAIT_L(0); PG8_MMA(1, 0, At, B0); PG8_BAR; PG8_SCHED;
            PG8_STAGE(PG8_SB(0, 1), b2 + hstep, voffB);
            PG8_WAIT_V(6); PG8_BAR; PG8_MMA(1, 1, At, B1); PG8_BAR;
            PG8_LDB(B0, 1, 0); PG8_SCHED; PG8_LDA(At, 1, 0); PG8_STAGE(PG8_SA(0, 1), a2 + hstep, voffA);
            PG8_WAIT_L(8); PG8_BAR; PG8_WAIT_L(0); PG8_MMA(0, 0, At, B0); PG8_BAR; PG8_SCHED;
            PG8_LDB(B1, 1, 1); PG8_STAGE(PG8_SB(1, 0), b3, voffB);
            PG8_BAR; PG8_WAIT_L(0); PG8_MMA(0, 1, At, B1); PG8_BAR;
            PG8_LDA(At, 1, 1); PG8_STAGE(PG8_SA(1, 0), a3, voffA);
            PG8_BAR; PG8_WAIT_L(0); PG8_MMA(1, 0, At, B0); PG8_BAR; PG8_SCHED;
            PG8_STAGE(PG8_SB(1, 1), b3 + hstep, voffB);
            PG8_WAIT_V(6); PG8_BAR; PG8_MMA(1, 1, At, B1); PG8_BAR;
            }
        }
        if constexpr (ALIGN_EPI) { if (wr == 0) PG8_BAR; }
        if constexpr (!Epi::AFTER_DRAIN) { E(acc, cur, wr, wc, fr, fq); S.done(cur); }
        if (!has_next) break;
#pragma unroll
        for (int a = 0; a < 2; ++a)
#pragma unroll
            for (int b = 0; b < 2; ++b)
#pragma unroll
                for (int m = 0; m < 4; ++m)
#pragma unroll
                    for (int n = 0; n < 2; ++n) acc[a][b][m][n] = (f32x4){0.f, 0.f, 0.f, 0.f};
        cur = nxt; cA = nA; cB = nB; ++ui;
        if constexpr (ALIGN_EPI) { if (wr == 1) PG8_BAR; }
    }
    PG8_WAIT_V(0);
    if constexpr (!ALIGN_EPI) { if (wr == 0) PG8_BAR; }
    PG8_BAR;
    if constexpr (Epi::AFTER_DRAIN) { E.fused(acc, cur, wr, wc, fr, fq, lds, wid, lane); S.done(cur); }
#undef PG8_SA
#undef PG8_SB
#undef PG8_STAGE
#undef PG8_LDA
#undef PG8_LDB
#undef PG8_MMA
#undef PG8_WAIT_V
#undef PG8_WAIT_L
#undef PG8_BAR
#undef PG8_SCHED
}
}

#define LAS __attribute__((address_space(3)))
typedef unsigned short bf16;
typedef float f32x4 __attribute__((ext_vector_type(4)));
typedef float f32x16 __attribute__((ext_vector_type(16)));
typedef short bf16x8 __attribute__((ext_vector_type(8)));
typedef short s16x4 __attribute__((ext_vector_type(4)));
typedef unsigned u32x2 __attribute__((ext_vector_type(2)));
typedef unsigned u32x4 __attribute__((ext_vector_type(4)));

constexpr int NWAVES = 8, NTHR = 512;
constexpr int BATCH = 4, SEQ = 4096, D = 2048, M = BATCH * SEQ, FF = 5632, NH = 16, HD = 128, NQKV = 3 * D;
constexpr float RMS_EPS = 1e-6f;
constexpr float LOG2E = 1.44269504089f;
constexpr float SC2 = 0.08838834764831845f * LOG2E;

constexpr size_t SZ_W1 = (size_t)2 * FF * D * 2, SZ_W2 = (size_t)D * FF * 2, SZ_WQKV = (size_t)NQKV * D * 2, SZ_WO = (size_t)D * D * 2;
constexpr size_t WS_W1 = 0, WS_W2 = WS_W1 + 4 * SZ_W1, WS_WQKV = WS_W2 + 4 * SZ_W2, WS_WO = WS_WQKV + 2 * SZ_WQKV;
constexpr size_t WS_U = WS_WO + 2 * SZ_WO;
constexpr size_t WS_BIG = WS_U + (size_t)M * D * 2;
constexpr size_t WS_O = WS_BIG + (size_t)M * NQKV * 2;
constexpr size_t WS_LSE = WS_O + (size_t)M * D * 2;
constexpr size_t WS_KMH = WS_LSE + (size_t)3 * M * 8 * 4;
constexpr size_t WS_KML = WS_KMH + (size_t)4 * BATCH * 8 * 16 * 128 * 4;
constexpr size_t WS_BIAS = WS_KML + (size_t)BATCH * 8 * 16 * 128 * 2;
constexpr size_t WS_BKT = WS_BIAS + (size_t)16 * 4096 * 4;
constexpr size_t WS_SS = WS_BKT + 4096;
constexpr size_t WS_KT = WS_SS + (size_t)7 * M * 32 * 4;
constexpr size_t WS_CTL = WS_KT + (size_t)M * D * 2;
constexpr size_t CTL_BYTES = 16384;
constexpr size_t WS_END = WS_CTL + CTL_BYTES;

constexpr int LDS_BYTES = 155648 + 64 + 1024;
#ifndef REP_GEMM
#define REP_GEMM 1
#endif
#ifndef REP_P0
#define REP_P0 1
#endif
#ifndef REP_NORM
#define REP_NORM 1
#endif
#ifndef REP_DIL
#define REP_DIL 1
#endif
#ifndef REP_MOBA
#define REP_MOBA 1
#endif
#ifndef REP_SB
#define REP_SB 1
#endif

struct Args { const float* in[11]; float* out; unsigned char* ws; };

__device__ __forceinline__ float wave_sum(float v) {
#pragma unroll
    for (int o = 1; o < 64; o <<= 1) v += __shfl_xor(v, o);
    return v;
}
__device__ __forceinline__ unsigned cvtpk(float lo, float hi) { return pg8::cvt_pk_bf16(lo, hi); }
template <class T> __device__ __forceinline__ T* as_global(T* p) { return (T*)(__attribute__((address_space(1))) T*)p; }

__device__ __forceinline__ void tr_item(const float* __restrict__ W, int N, bf16* __restrict__ WT, int K, int k0, int n0, int drow0, int lane, const float* __restrict__ gain) {
    const int c = lane & 7, n4 = lane >> 3;
    const float* src = W + (size_t)(k0 + 8 * c) * N + n0 + 4 * n4;
    f32x4 v[8];
#pragma unroll
    for (int j = 0; j < 8; ++j) v[j] = __builtin_nontemporal_load((const f32x4*)(src + (size_t)j * N));
    if (gain) {
        const f32x4 g0 = *(const f32x4*)(gain + k0 + 8 * c), g1 = *(const f32x4*)(gain + k0 + 8 * c + 4);
        v[0] *= g0[0]; v[1] *= g0[1]; v[2] *= g0[2]; v[3] *= g0[3]; v[4] *= g1[0]; v[5] *= g1[1]; v[6] *= g1[2]; v[7] *= g1[3]; }
    bf16* dst = WT + (size_t)(drow0 + 4 * n4) * K + k0 + 8 * c;
#pragma unroll
    for (int e = 0; e < 4; ++e) {
        u32x4 o; o.x = cvtpk(v[0][e], v[1][e]); o.y = cvtpk(v[2][e], v[3][e]); o.z = cvtpk(v[4][e], v[5][e]); o.w = cvtpk(v[6][e], v[7][e]);
        *(u32x4*)(dst + (size_t)e * K) = o; }
}
__device__ __forceinline__ void p0_weights(const Args& a, int gw, int NGW, int lane) {
    constexpr int I_F = (D / 64) * (FF / 32);
    constexpr int I_Q = (D / 64) * (NQKV / 32);
    constexpr int I_O = (D / 64) * (D / 32);
    constexpr int NITEMS = 12 * I_F + 2 * I_Q + 2 * I_O;
    unsigned char* ws = as_global(a.ws);
    for (int it = gw; it < NITEMS; it += NGW) {
        if (it < 12 * I_F) {
            const int seg = it / I_F, r = it - seg * I_F, kind = seg >> 2, idx = seg & 3;
            if (kind < 2) {
                const float* W = as_global(a.in[2 + kind]) + (size_t)idx * D * FF;
                const int nnb = FF / 32, kb = r / nnb, nb = r - kb * nnb, n0 = nb * 32;
                tr_item(W, FF, (bf16*)(ws + WS_W1 + idx * SZ_W1), D, kb * 64, n0, (n0 >> 7) * 256 + kind * 128 + (n0 & 127), lane, as_global(a.in[1]) + (size_t)((idx >> 1) * 3 + (idx & 1) * 2) * D);
            } else {
                const float* W = as_global(a.in[4]) + (size_t)idx * FF * D;
                const int nnb = D / 32, kb = r / nnb, nb = r - kb * nnb, n0 = nb * 32;
                tr_item(W, D, (bf16*)(ws + WS_W2 + idx * SZ_W2), FF, kb * 64, n0, n0, lane, nullptr);
            }
        } else {
            int r = it - 12 * I_F;
            if (r < 2 * I_Q) { const int l = r / I_Q; r -= l * I_Q; const float* W = as_global(a.in[l == 0 ? 5 : 7]);
                const int nnb = NQKV / 32, kb = r / nnb, nb = r - kb * nnb, n0 = nb * 32;
                tr_item(W, NQKV, (bf16*)(ws + WS_WQKV + l * SZ_WQKV), D, kb * 64, n0, n0, lane, as_global(a.in[1]) + (size_t)(l * 3 + 1) * D);
            } else { r -= 2 * I_Q; const int l = r / I_O; r -= l * I_O; const float* W = as_global(a.in[l == 0 ? 6 : 8]);
                const int nnb = D / 32, kb = r / nnb, nb = r - kb * nnb, n0 = nb * 32;
                tr_item(W, D, (bf16*)(ws + WS_WO + l * SZ_WO), D, kb * 64, n0, n0, lane, nullptr);
            }
        }
    }
}
__device__ __forceinline__ void p0_bias(const Args& a, int gtid, int gthreads) {
    float* bt = (float*)(as_global(a.ws) + WS_BIAS); const float* rb = as_global(a.in[9]);
    for (int i = gtid; i < 16 * 4096; i += gthreads) {
        const int h = i >> 12, d = i & 4095; int bk;
        if (d < 16) bk = d; else { const float df = (float)d; int lg = 16 + (int)(logf(df / 16.0f) / logf(128.0f) * 16.0f); bk = lg < 31 ? lg : 31; }
        bt[i] = rb[bk * 16 + h] * LOG2E;
        if (h == 0) (as_global(a.ws) + WS_BKT)[d] = (unsigned char)bk;
    }
}
template <bool TO_F32>
__device__ __forceinline__ void rms_row(const float* xrow, const float* g, void* orow, int lane) {
    const f32x4* xr = (const f32x4*)xrow + lane; const f32x4* gr = (const f32x4*)g + lane;
    f32x4 v[8]; float s = 0.f;
#pragma unroll
    for (int j = 0; j < 8; ++j) { v[j] = xr[64 * j]; s += (v[j].x * v[j].x + v[j].y * v[j].y) + (v[j].z * v[j].z + v[j].w * v[j].w); }
    const float rstd = 1.0f / sqrtf(wave_sum(s) * (1.0f / D) + RMS_EPS);
#pragma unroll
    for (int j = 0; j < 8; ++j) { const f32x4 gg = gr[64 * j]; const f32x4 y = v[j] * rstd * gg;
        if (TO_F32) ((f32x4*)orow)[lane + 64 * j] = y;
        else { u32x2 w; w.x = cvtpk(y.x, y.y); w.y = cvtpk(y.z, y.w); ((u32x2*)orow)[lane + 64 * j] = w; } }
}

__device__ __forceinline__ void x_row(const float* xrow, bf16* orow, float* ss, int lane) {
    const f32x4* xr = (const f32x4*)xrow + lane; float s = 0.f;
#pragma unroll
    for (int j = 0; j < 8; ++j) { const f32x4 v = xr[64 * j]; u32x2 w; w.x = cvtpk(v.x, v.y); w.y = cvtpk(v.z, v.w); ((u32x2*)orow)[lane + 64 * j] = w;
        const float r0 = __uint_as_float(w.x << 16), r1 = __uint_as_float(w.x & 0xffff0000u), r2 = __uint_as_float(w.y << 16), r3 = __uint_as_float(w.y & 0xffff0000u);
        s += (r0 * r0 + r1 * r1) + (r2 * r2 + r3 * r3); }
    s = wave_sum(s);
    if (lane < 32) ss[lane] = s * (1.0f / 32.0f);
}
__device__ __forceinline__ void final_row(float* orow, const bf16* hrow, const float* g, const float* ss, int lane) {
    const float rstd = 1.0f / sqrtf(wave_sum(lane < 32 ? ss[lane] : 0.f) * (1.0f / D) + RMS_EPS);
    f32x4* xr = (f32x4*)orow + lane; const f32x4* gr = (const f32x4*)g + lane; const u32x2* hr = (const u32x2*)hrow + lane;
#pragma unroll
    for (int j = 0; j < 8; ++j) { const u32x2 a = hr[64 * j]; f32x4 v;
        v.x = __uint_as_float(a.x << 16); v.y = __uint_as_float(a.x & 0xffff0000u); v.z = __uint_as_float(a.y << 16); v.w = __uint_as_float(a.y & 0xffff0000u);
        xr[64 * j] = v * rstd * gr[64 * j]; }
}

#define MFMA32(a, b, c) __builtin_amdgcn_mfma_f32_32x32x16_bf16(a, b, c, 0, 0, 0)
struct WCtx { int lane, q, h; LAS unsigned char* vbuf; unsigned wb[4]; unsigned trb0, trb1; };
__device__ __forceinline__ void wctx_init(WCtx& w, LAS unsigned char* vbuf, int lane) {
    w.lane = lane; w.q = lane & 31; w.h = lane >> 5; w.vbuf = vbuf;
    const int ch = lane & 15, kr = lane >> 4;
#pragma unroll
    for (int x = 0; x < 4; ++x) w.wb[x] = (unsigned)(512 * (ch >> 2) + 64 * kr + 16 * ((ch & 3) ^ x));
    const int qq = (lane & 15) >> 2, p = lane & 3, blk = (lane >> 4) & 1, h = lane >> 5;
    const int x0 = (2 * blk + (p >> 1)) ^ (2 * h);
    w.trb0 = (unsigned)(2048 * h + 64 * qq + 16 * x0 + 8 * (p & 1));
    w.trb1 = (unsigned)(2048 * h + 256 + 64 * qq + 16 * (x0 ^ 1) + 8 * (p & 1));
}
__device__ __forceinline__ void load_q(const bf16* qrow  , bf16x8 (&qf)[8]) {
#pragma unroll
    for (int s = 0; s < 8; ++s) qf[s] = *(const bf16x8*)(qrow + 16 * s);
}
__device__ __forceinline__ f32x16 qk_tile(const bf16* krow  , const bf16x8 (&qf)[8]) {
    bf16x8 kf[8];
#pragma unroll
    for (int s = 0; s < 8; ++s) kf[s] = *(const bf16x8*)(krow + 16 * s);
    f32x16 acc;
#pragma unroll
    for (int i = 0; i < 16; ++i) acc[i] = 0.f;
#pragma unroll
    for (int s = 0; s < 8; ++s) acc = MFMA32(kf[s], qf[s], acc);
    return acc;
}
__device__ __forceinline__ void load_v(const bf16* vt, size_t stride, const WCtx& w, u32x4 (&vr)[8]) {
    const bf16* p = vt + (size_t)(w.lane >> 4) * stride + (w.lane & 15) * 8;
#pragma unroll
    for (int i = 0; i < 8; ++i) vr[i] = *(const u32x4*)(p + (size_t)(4 * i) * stride);
}
__device__ __forceinline__ void stage_v(const WCtx& w, const u32x4 (&vr)[8]) {
#pragma unroll
    for (int i = 0; i < 8; ++i)
        *(LAS u32x4*)(w.vbuf + (2048 * ((i & 1) + 2 * (i >> 2)) + 256 * ((i >> 1) & 1)) + w.wb[((i >> 1) & 1) + 2 * (i & 1)]) = vr[i];
}
__device__ __forceinline__ void pv_tile(const WCtx& w, const bf16x8 (&pf)[2], f32x16 (&o)[4]) {
#pragma unroll
    for (int ks = 0; ks < 2; ++ks)
#pragma unroll
        for (int c = 0; c < 4; ++c) {
            const s16x4 lo = __builtin_amdgcn_ds_read_tr16_b64_v4i16((LAS s16x4*)(w.vbuf + w.trb0 + 4096 * ks + 512 * c));
            const s16x4 hi = __builtin_amdgcn_ds_read_tr16_b64_v4i16((LAS s16x4*)(w.vbuf + w.trb1 + 4096 * ks + 512 * c));
            bf16x8 a; a[0] = lo[0]; a[1] = lo[1]; a[2] = lo[2]; a[3] = lo[3]; a[4] = hi[0]; a[5] = hi[1]; a[6] = hi[2]; a[7] = hi[3];
            o[c] = MFMA32(a, pf[ks], o[c]);
        }
}
__device__ __forceinline__ void pv_tile_b(const LAS unsigned char* vimg, const WCtx& w, const bf16x8 (&pf)[2], f32x16 (&o)[4]) {
#pragma unroll
    for (int ks = 0; ks < 2; ++ks)
#pragma unroll
        for (int c = 0; c < 4; ++c) {
            const s16x4 lo = __builtin_amdgcn_ds_read_tr16_b64_v4i16((LAS s16x4*)(vimg + w.trb0 + 4096 * ks + 512 * c));
            const s16x4 hi = __builtin_amdgcn_ds_read_tr16_b64_v4i16((LAS s16x4*)(vimg + w.trb1 + 4096 * ks + 512 * c));
            bf16x8 a; a[0] = lo[0]; a[1] = lo[1]; a[2] = lo[2]; a[3] = lo[3]; a[4] = hi[0]; a[5] = hi[1]; a[6] = hi[2]; a[7] = hi[3];
            o[c] = MFMA32(a, pf[ks], o[c]);
        }
}
__device__ __forceinline__ void pack_p(const float (&p)[16], bf16x8 (&pf)[2]) {
#pragma unroll
    for (int ks = 0; ks < 2; ++ks) {
        u32x4 w; w.x = cvtpk(p[8 * ks + 0], p[8 * ks + 1]); w.y = cvtpk(p[8 * ks + 2], p[8 * ks + 3]); w.z = cvtpk(p[8 * ks + 4], p[8 * ks + 5]); w.w = cvtpk(p[8 * ks + 6], p[8 * ks + 7]);
        pf[ks] = __builtin_bit_cast(bf16x8, w); }
}
__device__ __forceinline__ float xh_max(float v) { const auto r = __builtin_amdgcn_permlane32_swap(__float_as_uint(v), __float_as_uint(v), false, false); return fmaxf(__uint_as_float(r[0]), __uint_as_float(r[1])); }
__device__ __forceinline__ float xh_sum(float v) { const auto r = __builtin_amdgcn_permlane32_swap(__float_as_uint(v), __float_as_uint(v), false, false); return __uint_as_float(r[0]) + __uint_as_float(r[1]); }
__device__ __forceinline__ float xh_other(float v, int h) { const auto r = __builtin_amdgcn_permlane32_swap(__float_as_uint(v), __float_as_uint(v), false, false); return __uint_as_float(h == 0 ? r[1] : r[0]); }
__device__ __forceinline__ void softmax_step(const float (&s)[16], float& m, float& l, f32x16 (&o)[4], bf16x8 (&pf)[2]) {
    float mx = s[0];
#pragma unroll
    for (int i = 1; i < 16; ++i) mx = fmaxf(mx, s[i]);
    mx = xh_max(mx);
    const float mn = fmaxf(m, mx), mu = (mn == -INFINITY) ? 0.f : mn;
    const float alpha = __builtin_amdgcn_exp2f(m - mu);
    float p[16], ps = 0.f;
#pragma unroll
    for (int i = 0; i < 16; ++i) { p[i] = __builtin_amdgcn_exp2f(s[i] - mu); ps += p[i]; }
    l = l * alpha + ps; m = mn;
    if (__builtin_amdgcn_ballot_w64(alpha != 1.0f) != 0ull) {
#pragma unroll
        for (int c = 0; c < 4; ++c)
#pragma unroll
            for (int i = 0; i < 16; ++i) o[c][i] *= alpha; }
    pack_p(p, pf);
}
__device__ __forceinline__ void write_o(const f32x16 (&o)[4], float mul, bf16* orow, int h) {
#pragma unroll
    for (int c = 0; c < 4; ++c)
#pragma unroll
        for (int g = 0; g < 4; ++g) { u32x2 w; w.x = cvtpk(o[c][4 * g] * mul, o[c][4 * g + 1] * mul); w.y = cvtpk(o[c][4 * g + 2] * mul, o[c][4 * g + 3] * mul);
            *(u32x2*)(orow + 32 * c + 8 * g + 4 * h) = w; }
}
#define ZERO_O(o) do { _Pragma("unroll") for (int c_ = 0; c_ < 4; ++c_) _Pragma("unroll") for (int i_ = 0; i_ < 16; ++i_) o[c_][i_] = 0.f; } while (0)

__device__ __forceinline__ void load_k(const bf16* krow  , bf16x8 (&kf)[8]) {
#pragma unroll
    for (int s = 0; s < 8; ++s) kf[s] = *(const bf16x8*)(krow + 16 * s);
}
__device__ __forceinline__ void load_kt(const bf16* kt  , bf16x8 (&kf)[8]) {
#pragma unroll
    for (int s = 0; s < 8; ++s) kf[s] = *(const bf16x8*)(kt + 512 * s);
}
__device__ __forceinline__ f32x16 qk_mma(const bf16x8 (&kf)[8], const bf16x8 (&qf)[8]) {
    f32x16 acc;
#pragma unroll
    for (int i = 0; i < 16; ++i) acc[i] = 0.f;
#pragma unroll
    for (int s = 0; s < 8; ++s) acc = MFMA32(kf[s], qf[s], acc);
    return acc;
}
__device__ __forceinline__ void load_vp(const bf16* p  , size_t stride, u32x4 (&vr)[8]) {
#pragma unroll
    for (int i = 0; i < 8; ++i) vr[i] = *(const u32x4*)(p + (size_t)(4 * i) * stride);
}

__device__ __forceinline__ void stage_k(LAS unsigned char* kimg, int lane, const u32x4 (&kr)[8]) {
    LAS unsigned char* p = kimg + ((unsigned)lane & 15u) * 528u + ((unsigned)lane >> 4) * 16u;
#pragma unroll
    for (int i = 0; i < 8; ++i) *(LAS u32x4*)(p + 64 * i) = kr[i];
}
__device__ __forceinline__ f32x16 qk_mma_img(const LAS unsigned char* kimg, int lane, const bf16x8 (&qf)[8]) {
    const LAS unsigned char* p = kimg + ((unsigned)lane >> 5) * 528u + ((unsigned)lane & 31u) * 16u;
    bf16x8 kf[8];
#pragma unroll
    for (int s = 0; s < 8; ++s) kf[s] = *(const LAS bf16x8*)(p + 1056 * s);
    return qk_mma(kf, qf);
}

__device__ __forceinline__ void dilated_wave(const bf16* qkv, int b, int head, int r, int c, int l0, bf16* obase, int o_ld, float* lse_out, const LAS float* btab, LAS unsigned char* kimg  , const WCtx& w) {
    const size_t tokq = (size_t)b * SEQ + (size_t)(l0 + w.q) * r + c;
    bf16x8 qf[8]; load_q(qkv + tokq * NQKV + head * HD + 8 * w.h, qf);
    f32x16 o[4]; ZERO_O(o); float m = -INFINITY, l = 0.f;
    const size_t vstride = (size_t)r * NQKV, tstep = 32 * vstride;
    int j = l0 >= 128 ? 0 : (128 - l0) >> 5;
    const size_t tok0 = (size_t)b * SEQ + (size_t)(l0 - 128 + 32 * j) * r + c;
    const bf16* vp = qkv + (tok0 + (size_t)(w.lane >> 4) * r) * NQKV + 2 * D + head * HD + (w.lane & 15) * 8;
    const bf16* kp = vp - D;
    u32x4 kr[8]; u32x4 vr[8]; load_vp(kp, vstride, kr); load_vp(vp, vstride, vr);
#pragma unroll 1
    for (;;) {
        stage_k(kimg, w.lane, kr);
        const f32x16 acc = qk_mma_img(kimg, w.lane, qf);
        const bool more = j < 4;
        if (more) { kp += tstep; load_vp(kp, vstride, kr); }
        float s[16];
#pragma unroll
        for (int i = 0; i < 16; ++i) { const int kk = 8 * (i >> 2) + 4 * w.h + (i & 3); const int rel = 128 - 32 * j + w.q - kk;
            const bool valid = ((j != 0) | (kk >= w.q)) & ((j != 4) | (kk <= w.q));
            const int dist = min(max(rel, 0), 128) * r;
            const float v = acc[i] * SC2 + btab[dist]; s[i] = fminf(v, valid ? INFINITY : -INFINITY); }
        bf16x8 pf[2]; softmax_step(s, m, l, o, pf);
        stage_v(w, vr);
        pv_tile(w, pf, o);
        if (!more) break;
        vp += tstep; load_vp(vp, vstride, vr);
        ++j;
    }
    const float lt = xh_sum(l), inv = 1.0f / lt;
    write_o(o, inv, obase + tokq * o_ld + head * HD, w.h);
    if (w.h == 0) lse_out[tokq * 8 + head] = m + __builtin_amdgcn_logf(lt);
}

__device__ __forceinline__ void moba_wave(const bf16* qkv, const bf16* KT, const float* kmq, int b, int hh, int t0, bf16* O, const LAS float* btab, const LAS unsigned char* bkt, const WCtx& w) {
    const int head = 8 + hh, own = t0 >> 8;
    const size_t tokq = (size_t)b * SEQ + t0 + w.q;
    bf16x8 qf[8]; load_q(qkv + tokq * NQKV + head * HD + 8 * w.h, qf);
    unsigned sel = (1u << own) - 1u;
    if (own > 3) {
        const int n = w.q & 15; const size_t ko = ((size_t)(b * 8 + hh) * 16 + n) * HD + 8 * w.h; constexpr size_t QS = (size_t)BATCH * 8 * 16 * HD;
        f32x16 g;
#pragma unroll
        for (int i = 0; i < 16; ++i) g[i] = 0.f;
#pragma unroll
        for (int s = 0; s < 8; ++s) {
            f32x4 a0 = *(const f32x4*)(kmq + ko + 16 * s), a1 = *(const f32x4*)(kmq + ko + 16 * s + 4);
#pragma unroll
            for (int qd = 1; qd < 4; ++qd) { a0 += *(const f32x4*)(kmq + qd * QS + ko + 16 * s); a1 += *(const f32x4*)(kmq + qd * QS + ko + 16 * s + 4); }
            a0 *= (1.0f / 256.0f); a1 *= (1.0f / 256.0f);
            u32x4 hi; hi.x = cvtpk(a0[0], a0[1]); hi.y = cvtpk(a0[2], a0[3]); hi.z = cvtpk(a1[0], a1[1]); hi.w = cvtpk(a1[2], a1[3]);
            u32x4 lo; lo.x = cvtpk(a0[0] - __uint_as_float(hi.x << 16), a0[1] - __uint_as_float(hi.x & 0xffff0000u)); lo.y = cvtpk(a0[2] - __uint_as_float(hi.y << 16), a0[3] - __uint_as_float(hi.y & 0xffff0000u));
            lo.z = cvtpk(a1[0] - __uint_as_float(hi.z << 16), a1[1] - __uint_as_float(hi.z & 0xffff0000u)); lo.w = cvtpk(a1[2] - __uint_as_float(hi.w << 16), a1[3] - __uint_as_float(hi.w & 0xffff0000u));
            g = MFMA32(__builtin_bit_cast(bf16x8, hi), qf[s], g); g = MFMA32(__builtin_bit_cast(bf16x8, lo), qf[s], g); }
        float pg[8], gv[16];
#pragma unroll
        for (int i = 0; i < 8; ++i) pg[i] = xh_other(g[i], w.h);
#pragma unroll
        for (int nn = 0; nn < 16; ++nn) { const int a = nn >> 3, bb = (nn >> 2) & 1, e = nn & 3; const float v = (bb == w.h) ? g[4 * a + e] : pg[4 * a + e]; gv[nn] = (nn < own) ? v : -INFINITY; }
        sel = 0u;
#pragma unroll
        for (int rd = 0; rd < 3; ++rd) { float best = -INFINITY; int bi = 0;
#pragma unroll
            for (int nn = 0; nn < 16; ++nn) { const bool take = !((sel >> nn) & 1u) && (gv[nn] > best); best = take ? gv[nn] : best; bi = take ? nn : bi; }
            sel |= 1u << bi; }
    }
    unsigned bm = 1u << own;
#pragma unroll
    for (int n = 0; n < 15; ++n) if (__builtin_amdgcn_ballot_w64((sel >> n) & 1u) != 0ull) bm |= 1u << n;
    const int jd = (t0 & 255) >> 5;
    f32x16 o[4]; ZERO_O(o); float m = -INFINITY, l = 0.f;
    const bf16* kb = KT + ((size_t)((b * 16 + head) * 128) << 12) + w.lane * 8;
    const bf16* vb = qkv + ((size_t)b * SEQ + (w.lane >> 4)) * NQKV + 2 * D + head * HD + (w.lane & 15) * 8;
    int nb = __builtin_ctz(bm), jj = 0;
    bf16x8 kf[8]; u32x4 vr[8];
    { load_kt(kb + ((size_t)(nb * 8) << 12), kf); load_vp(vb + (size_t)(nb * 256) * NQKV, NQKV, vr); }
#pragma unroll 1
    for (;;) {
        const f32x16 acc = qk_mma(kf, qf);
        int nb2 = nb, jj2 = jj + 1; unsigned bm2 = bm;
        if (jj2 > (nb == own ? jd : 7)) { bm2 &= bm2 - 1u; jj2 = 0; nb2 = bm2 ? __builtin_ctz(bm2) : 0; }
        const bool more = bm2 != 0u;
        const size_t ko2 = (size_t)(nb2 * 256 + 32 * jj2) * NQKV;
        if (more) load_kt(kb + ((size_t)(nb2 * 8 + jj2) << 12), kf);
        const int key0 = nb * 256 + 32 * jj, dq = t0 - key0 + w.q - 4 * w.h;
        const bool rowsel = (nb == own) || ((sel >> nb) & 1u);
        float s[16];
        const int dlt = t0 - key0;
        bool uni = false;
        if (dlt >= 31) uni = __builtin_amdgcn_readfirstlane((int)bkt[dlt - 31]) == __builtin_amdgcn_readfirstlane((int)bkt[dlt + 31]);
        if (uni) {
            const float bu = btab[dlt], lim = rowsel ? INFINITY : -INFINITY;
#pragma unroll
            for (int i = 0; i < 16; ++i) s[i] = fminf(acc[i] * SC2 + bu, lim);
        } else {
#pragma unroll
            for (int i = 0; i < 16; ++i) { const int dist = dq - (8 * (i >> 2) + (i & 3)); const bool valid = rowsel && dist >= 0; const float v = acc[i] * SC2 + btab[max(dist, 0)]; s[i] = fminf(v, valid ? INFINITY : -INFINITY); }
        }
        bf16x8 pf[2]; softmax_step(s, m, l, o, pf);
        stage_v(w, vr);
        pv_tile(w, pf, o);
        if (!more) break;
        load_vp(vb + ko2, NQKV, vr);
        nb = nb2; jj = jj2; bm = bm2;
    }
    const float lt = xh_sum(l), inv = 1.0f / lt;
    write_o(o, inv, O + tokq * D + head * HD, w.h);
}

__device__ __forceinline__ void moba_logits(const f32x16& acc, int t0, int key0, bool rowsel, const LAS float* btab, const LAS unsigned char* bkt, const WCtx& w, float (&s)[16]) {
    const int dlt = t0 - key0, dq = dlt + w.q - 4 * w.h;
    bool uni = false;
    if (dlt >= 31) uni = __builtin_amdgcn_readfirstlane((int)bkt[dlt - 31]) == __builtin_amdgcn_readfirstlane((int)bkt[dlt + 31]);
    if (uni) {
        const float bu = btab[dlt], lim = rowsel ? INFINITY : -INFINITY;
#pragma unroll
        for (int i = 0; i < 16; ++i) s[i] = fminf(acc[i] * SC2 + bu, lim);
    } else {
#pragma unroll
        for (int i = 0; i < 16; ++i) { const int dist = dq - (8 * (i >> 2) + (i & 3)); const bool valid = rowsel && dist >= 0; const float v = acc[i] * SC2 + btab[max(dist, 0)]; s[i] = fminf(v, valid ? INFINITY : -INFINITY); }
    }
}
__device__ __forceinline__ void softmax_step2(const float (&sa)[16], const float (&sb)[16], float& m, float& l, f32x16 (&o)[4], bf16x8 (&pfa)[2], bf16x8 (&pfb)[2]) {
    float mx = fmaxf(sa[0], sb[0]);
#pragma unroll
    for (int i = 1; i < 16; ++i) mx = fmaxf(mx, fmaxf(sa[i], sb[i]));
    mx = xh_max(mx);
    const float mn = fmaxf(m, mx), mu = (mn == -INFINITY) ? 0.f : mn;
    const float alpha = __builtin_amdgcn_exp2f(m - mu);
    float pa[16], pb[16], ps = 0.f;
#pragma unroll
    for (int i = 0; i < 16; ++i) { pa[i] = __builtin_amdgcn_exp2f(sa[i] - mu); pb[i] = __builtin_amdgcn_exp2f(sb[i] - mu); ps += pa[i] + pb[i]; }
    l = l * alpha + ps; m = mn;
    if (__builtin_amdgcn_ballot_w64(alpha != 1.0f) != 0ull) {
#pragma unroll
        for (int c = 0; c < 4; ++c)
#pragma unroll
            for (int i = 0; i < 16; ++i) o[c][i] *= alpha; }
    pack_p(pa, pfa); pack_p(pb, pfb);
}

__device__ __forceinline__ void moba_wg(const bf16* qkv, const bf16* KT, const float* kmq, int b, int hh, int own, int wave, int tid, bf16* O, const LAS float* btab, const LAS unsigned char* bkt, LAS unsigned char* lds, const WCtx& w) {
    const int head = 8 + hh, t0 = own * 256 + wave * 32;
    const size_t tokq = (size_t)b * SEQ + t0 + w.q;
    bf16x8 qf[8]; load_q(qkv + tokq * NQKV + head * HD + 8 * w.h, qf);
    unsigned sel = (1u << own) - 1u;
    if (own > 3) {
        const int n = w.q & 15; const size_t ko = ((size_t)(b * 8 + hh) * 16 + n) * HD + 8 * w.h; constexpr size_t QS = (size_t)BATCH * 8 * 16 * HD;
        f32x16 g;
#pragma unroll
        for (int i = 0; i < 16; ++i) g[i] = 0.f;
#pragma unroll
        for (int s = 0; s < 8; ++s) {
            f32x4 a0 = *(const f32x4*)(kmq + ko + 16 * s), a1 = *(const f32x4*)(kmq + ko + 16 * s + 4);
#pragma unroll
            for (int qd = 1; qd < 4; ++qd) { a0 += *(const f32x4*)(kmq + qd * QS + ko + 16 * s); a1 += *(const f32x4*)(kmq + qd * QS + ko + 16 * s + 4); }
            a0 *= (1.0f / 256.0f); a1 *= (1.0f / 256.0f);
            u32x4 hi; hi.x = cvtpk(a0[0], a0[1]); hi.y = cvtpk(a0[2], a0[3]); hi.z = cvtpk(a1[0], a1[1]); hi.w = cvtpk(a1[2], a1[3]);
            u32x4 lo; lo.x = cvtpk(a0[0] - __uint_as_float(hi.x << 16), a0[1] - __uint_as_float(hi.x & 0xffff0000u)); lo.y = cvtpk(a0[2] - __uint_as_float(hi.y << 16), a0[3] - __uint_as_float(hi.y & 0xffff0000u));
            lo.z = cvtpk(a1[0] - __uint_as_float(hi.z << 16), a1[1] - __uint_as_float(hi.z & 0xffff0000u)); lo.w = cvtpk(a1[2] - __uint_as_float(hi.w << 16), a1[3] - __uint_as_float(hi.w & 0xffff0000u));
            g = MFMA32(__builtin_bit_cast(bf16x8, hi), qf[s], g); g = MFMA32(__builtin_bit_cast(bf16x8, lo), qf[s], g); }
        float pg[8], gv[16];
#pragma unroll
        for (int i = 0; i < 8; ++i) pg[i] = xh_other(g[i], w.h);
#pragma unroll
        for (int nn = 0; nn < 16; ++nn) { const int a = nn >> 3, bb = (nn >> 2) & 1, e = nn & 3; const float v = (bb == w.h) ? g[4 * a + e] : pg[4 * a + e]; gv[nn] = (nn < own) ? v : -INFINITY; }
        sel = 0u;
#pragma unroll
        for (int rd = 0; rd < 3; ++rd) { float best = -INFINITY; int bi = 0;
#pragma unroll
            for (int nn = 0; nn < 16; ++nn) { const bool take = !((sel >> nn) & 1u) && (gv[nn] > best); best = take ? gv[nn] : best; bi = take ? nn : bi; }
            sel |= 1u << bi; }
    }
    unsigned bmw = 1u << own;
#pragma unroll
    for (int n = 0; n < 15; ++n) if (__builtin_amdgcn_ballot_w64((sel >> n) & 1u) != 0ull) bmw |= 1u << n;
    LAS unsigned* wgw = (LAS unsigned*)(lds + 86016);
    if (tid == 0) wgw[0] = 0u;
    __syncthreads();
    if (w.lane == 0) __hip_atomic_fetch_or(wgw, bmw, __ATOMIC_RELAXED, __HIP_MEMORY_SCOPE_WORKGROUP);
    __syncthreads();
    unsigned bm = (unsigned)__builtin_amdgcn_readfirstlane((int)wgw[0]);
    f32x16 o[4]; ZERO_O(o); float m = -INFINITY, l = 0.f;
    const bf16* kg = KT + ((size_t)((b * 16 + head) * 128) << 12) + tid * 8;
    const bf16* vg = qkv + ((size_t)b * SEQ + (tid >> 4)) * NQKV + 2 * D + head * HD + (tid & 15) * 8;
    const unsigned kst = (unsigned)tid * 16u;
    unsigned vst; { const int kr = w.lane >> 4, ch = w.lane & 15, x = ((wave >> 1) & 1) + 2 * (wave & 1);
        vst = (unsigned)(8192 + 2048 * ((wave & 1) + 2 * (wave >> 2)) + 256 * ((wave >> 1) & 1) + 512 * (ch >> 2) + 64 * kr + 16 * ((ch & 3) ^ x)); }
    int nb = __builtin_ctz(bm), u = 0, buf = 0;
    u32x4 kra, vra, krb, vrb;
    { const size_t t = (size_t)(nb * 8); const size_t k0 = (size_t)(nb * 256) * NQKV;
      kra = *(const u32x4*)(kg + (t << 12)); krb = *(const u32x4*)(kg + ((t + 1) << 12)); vra = *(const u32x4*)(vg + k0); vrb = *(const u32x4*)(vg + k0 + (size_t)32 * NQKV); }
    *(LAS u32x4*)(lds + kst) = kra; *(LAS u32x4*)(lds + vst) = vra; *(LAS u32x4*)(lds + 16384 + kst) = krb; *(LAS u32x4*)(lds + 16384 + vst) = vrb;
    __syncthreads();
#pragma unroll 1
    for (;;) {
        int nb2 = nb, u2 = u + 1; unsigned bm2 = bm;
        if (u2 > 3) { bm2 &= bm2 - 1u; u2 = 0; nb2 = bm2 ? __builtin_ctz(bm2) : 0; }
        const bool more = bm2 != 0u;
        if (more) { const size_t t = (size_t)(nb2 * 8 + 2 * u2); const size_t k0 = (size_t)(nb2 * 256 + 64 * u2) * NQKV;
            kra = *(const u32x4*)(kg + (t << 12)); krb = *(const u32x4*)(kg + ((t + 1) << 12)); vra = *(const u32x4*)(vg + k0); vrb = *(const u32x4*)(vg + k0 + (size_t)32 * NQKV); }
        const bool mine = ((bmw >> nb) & 1u) && (nb != own || 2 * u <= wave);
        if (mine) {
            const LAS unsigned char* base = lds + buf * 32768;
            const LAS unsigned char* kimg = base + w.lane * 16;
            bf16x8 kfa[8], kfb[8];
#pragma unroll
            for (int s = 0; s < 8; ++s) { kfa[s] = *(const LAS bf16x8*)(kimg + 1024 * s); kfb[s] = *(const LAS bf16x8*)(kimg + 16384 + 1024 * s); }
            f32x16 acca, accb;
#pragma unroll
            for (int i = 0; i < 16; ++i) { acca[i] = 0.f; accb[i] = 0.f; }
#pragma unroll
            for (int s = 0; s < 8; ++s) { acca = MFMA32(kfa[s], qf[s], acca); accb = MFMA32(kfb[s], qf[s], accb); }
            const int key0 = nb * 256 + 64 * u;
            const bool rowsel = (nb == own) || ((sel >> nb) & 1u);
            float sa[16], sb[16];
            moba_logits(acca, t0, key0, rowsel, btab, bkt, w, sa);
            moba_logits(accb, t0, key0 + 32, rowsel, btab, bkt, w, sb);
            bf16x8 pfa[2], pfb[2]; softmax_step2(sa, sb, m, l, o, pfa, pfb);
            pv_tile_b(base + 8192, w, pfa, o);
            pv_tile_b(base + 16384 + 8192, w, pfb, o);
        }
        if (more) { LAS unsigned char* nb_ = lds + (buf ^ 1) * 32768;
            *(LAS u32x4*)(nb_ + kst) = kra; *(LAS u32x4*)(nb_ + vst) = vra; *(LAS u32x4*)(nb_ + 16384 + kst) = krb; *(LAS u32x4*)(nb_ + 16384 + vst) = vrb; }
        __syncthreads();
        if (!more) break;
        nb = nb2; u = u2; bm = bm2; buf ^= 1;
    }
    const float lt = xh_sum(l), inv = 1.0f / lt;
    write_o(o, inv, O + tokq * D + head * HD, w.h);
}

__device__ __forceinline__ void sb_wave(const bf16* qkv, const bf16* KT, int b, int head, int t0, bf16* O, const WCtx& w) {
    const size_t tokq = (size_t)b * SEQ + t0 + w.q;
    bf16x8 qf[8]; load_q(qkv + tokq * NQKV + head * HD + 8 * w.h, qf);
    f32x16 o[4]; ZERO_O(o); float carry = 1.f;
    const bf16* kp = KT + ((size_t)((b * 16 + head) * 128 + (t0 >> 5)) << 12) + w.lane * 8;
    const bf16* vp = qkv + ((size_t)b * SEQ + t0 + (w.lane >> 4)) * NQKV + 2 * D + head * HD + (w.lane & 15) * 8;
    bf16x8 kf[8]; u32x4 vr[8]; load_kt(kp, kf); load_vp(vp, NQKV, vr);
    int kt = t0 >> 5; const int ktd = kt;
#pragma unroll 1
    for (;;) {
        const f32x16 acc = qk_mma(kf, qf);
        const bool diag = (kt == ktd), notlast = kt > 0;
        if (notlast) { kp -= 4096; load_kt(kp, kf); }
        float sg_[16], kp_[16];
#pragma unroll
        for (int i = 0; i < 16; ++i) { const float z = acc[i] * SC2, e = __builtin_amdgcn_exp2f(-fabsf(z)), r = __builtin_amdgcn_rcpf(1.0f + e), sm = e * r; const bool pos = z >= 0.f;
            sg_[i] = pos ? r : sm; kp_[i] = pos ? sm : r; }
        if (diag) {
#pragma unroll
            for (int i = 0; i < 16; ++i) { const int kk = 8 * (i >> 2) + 4 * w.h + (i & 3); const bool past = kk < w.q; sg_[i] = past ? sg_[i] : 0.f; kp_[i] = past ? kp_[i] : 1.f; } }
        float sg[4], pg[4];
#pragma unroll
        for (int g = 0; g < 4; ++g) { sg[g] = (kp_[4 * g] * kp_[4 * g + 1]) * (kp_[4 * g + 2] * kp_[4 * g + 3]); pg[g] = xh_other(sg[g], w.h); }
        float run = 1.f, p[16];
#pragma unroll
        for (int g = 3; g >= 0; --g) {
            float bt = carry * run * (w.h == 0 ? pg[g] : 1.f);
#pragma unroll
            for (int e = 3; e >= 0; --e) { p[4 * g + e] = sg_[4 * g + e] * bt; bt *= kp_[4 * g + e]; }
            run *= sg[g] * pg[g]; }
        carry *= run;
        bf16x8 pf[2]; pack_p(p, pf);
        const bool more = notlast && (__builtin_amdgcn_ballot_w64(carry > 0.0f) != 0ull);
        stage_v(w, vr);
        pv_tile(w, pf, o);
        if (!more) break;
        vp -= (size_t)32 * NQKV; load_vp(vp, NQKV, vr);
        --kt;
    }
    write_o(o, 1.0f, O + tokq * D + head * HD, w.h);
}

__device__ __forceinline__ void kmean_wave(const bf16* KT, float* kmq, int wt, int lane) {
    const int qd = wt & 3, n = (wt >> 2) & 15, hh = (wt >> 6) & 7, b = wt >> 9;
    const bf16* kp = KT + ((size_t)((b * 16 + 8 + hh) * 128 + n * 8 + qd * 2) << 12) + (lane >> 3) * 512 + ((lane >> 2) & 1) * 256 + 2 * (lane & 3);
    float s0 = 0.f, s1 = 0.f;
#pragma unroll 16
    for (int j = 0; j < 64; ++j) { const unsigned v = *(const unsigned*)(kp + (size_t)(j >> 5) * 4096 + (j & 31) * 8); s0 += __uint_as_float(v << 16); s1 += __uint_as_float(v & 0xffff0000u); }
    float* o = kmq + (size_t)qd * BATCH * 8 * 16 * HD + ((size_t)(b * 8 + hh) * 16 + n) * HD + 2 * lane;
    o[0] = s0; o[1] = s1;
}
__device__ __forceinline__ void combine_wave(bf16* O, const bf16* br1, const bf16* br2, const float* lse, int tok, int lane) {
    const int head = lane >> 3, d0 = (lane & 7) * 16;
    const float l0 = lse[(size_t)tok * 8 + head], l1 = lse[(size_t)M * 8 + (size_t)tok * 8 + head], l2 = lse[(size_t)2 * M * 8 + (size_t)tok * 8 + head];
    const float mx = fmaxf(l0, fmaxf(l1, l2)); float a0 = __builtin_amdgcn_exp2f(l0 - mx), a1 = __builtin_amdgcn_exp2f(l1 - mx), a2 = __builtin_amdgcn_exp2f(l2 - mx);
    const float inv = 1.0f / (a0 + a1 + a2); a0 *= inv; a1 *= inv; a2 *= inv;
    bf16* po = O + (size_t)tok * D + head * HD + d0; const bf16* p1 = br1 + (size_t)tok * 1024 + head * HD + d0; const bf16* p2 = br2 + (size_t)tok * 1024 + head * HD + d0;
#pragma unroll
    for (int k = 0; k < 2; ++k) {
        const u32x4 x0 = *(const u32x4*)(po + 8 * k), x1 = *(const u32x4*)(p1 + 8 * k), x2 = *(const u32x4*)(p2 + 8 * k); u32x4 y;
#pragma unroll
        for (int e = 0; e < 4; ++e) {
            const float lo = a0 * __uint_as_float(x0[e] << 16) + a1 * __uint_as_float(x1[e] << 16) + a2 * __uint_as_float(x2[e] << 16);
            const float hi = a0 * __uint_as_float(x0[e] & 0xffff0000u) + a1 * __uint_as_float(x1[e] & 0xffff0000u) + a2 * __uint_as_float(x2[e] & 0xffff0000u);
            y[e] = cvtpk(lo, hi); }
        *(u32x4*)(po + 8 * k) = y; }
}

template <class T> __device__ __forceinline__ T* opaque(T* p) {
    unsigned lo = __builtin_amdgcn_readfirstlane((unsigned)(unsigned long long)p), hi = __builtin_amdgcn_readfirstlane((unsigned)((unsigned long long)p >> 32));
    asm volatile("" : "+s"(lo), "+s"(hi)); return (T*)(__attribute__((address_space(1))) T*)(((unsigned long long)hi << 32) | lo); }
__device__ __forceinline__ int opaque_v(int v) { asm volatile("" : "+v"(v)); return v; }

#define RLX_AGENT __ATOMIC_RELAXED, __HIP_MEMORY_SCOPE_AGENT
#define XB_TMO      128
#define XB_XCNT(j)  (256  + 64 * (j))
#define XB_XSUB(j)  (1280 + 64 * (j))
#define XB_XGEN(j)  (2304 + 64 * (j))
#define XB_TOP      3328
#define XB_TOPGEN   3392
#define XCD_BAR_WORDS 3456
#define XB_SPIN_CAP (1u << 18)

__device__ __forceinline__ unsigned xb_ld(unsigned* p)              { return __hip_atomic_load(p, __ATOMIC_RELAXED, __HIP_MEMORY_SCOPE_AGENT); }
__device__ __forceinline__ unsigned xb_add(unsigned* p, unsigned v) { return __hip_atomic_fetch_add(p, v, __ATOMIC_RELAXED, __HIP_MEMORY_SCOPE_AGENT); }
__device__ __forceinline__ unsigned xb_xcc_id() { return (unsigned)__builtin_amdgcn_s_getreg((3 << 11) | 20) & 0xFu; }
#define XB_SPIN(cond, bar) do { unsigned _sp = 0; while (cond) { __builtin_amdgcn_s_sleep(1); \
    if ((++_sp & 255u) == 0u) { if (xb_ld(&(bar)[XB_TMO])) break; if (_sp > XB_SPIN_CAP) { atomicAdd(&(bar)[XB_TMO], 1u); break; } } } } while (0)

struct XcdBarrier {
    int wv;
    unsigned* bar; unsigned x;
    volatile LAS unsigned* st;
};

__device__ __forceinline__ XcdBarrier xcd_barrier_post(unsigned* bar, volatile LAS unsigned* st) {
    XcdBarrier b; b.wv = __builtin_amdgcn_readfirstlane((int)(threadIdx.x >> 6)); b.bar = bar; b.x = xb_xcc_id(); b.st = st;
    if (threadIdx.x == 0) (void)xb_add(&bar[XB_XCNT(b.x)], 1u);
    return b;
}
__device__ __forceinline__ void xcd_barrier_complete(unsigned* bar, unsigned x, unsigned& nloc, unsigned& nx) {
    const unsigned G = gridDim.x * gridDim.y * gridDim.z;
    unsigned sum, cnt, mine, sp = 0u;
    for (;;) {
        sum = 0u; cnt = 0u; mine = 0u;
#pragma unroll
        for (unsigned j = 0; j < 16; ++j) { const unsigned c = xb_ld(&bar[XB_XCNT(j)]); sum += c; cnt += (c > 0u) ? 1u : 0u; mine = (j == x) ? c : mine; }
        if (sum == G) break;
        __builtin_amdgcn_s_sleep(1);
        if ((++sp & 255u) == 0u) { if (xb_ld(&bar[XB_TMO])) break; if (sp > XB_SPIN_CAP) { atomicAdd(&bar[XB_TMO], 1u); break; } }
    }
    nloc = mine > 0u ? mine : 1u; nx = cnt > 0u ? cnt : 1u;
}

__device__ __forceinline__ void xcd_barrier(const XcdBarrier& b) {
    asm volatile("s_waitcnt vmcnt(0)" ::: "memory");
    __syncthreads();
    if (b.wv == 0 && pg8::lane_id() == 0) {
        unsigned* bar = b.bar;
        __builtin_amdgcn_s_waitcnt(0);
        unsigned nloc = b.st[0], nx = b.st[1];
        if (nloc == 0u) { xcd_barrier_complete(bar, b.x, nloc, nx); b.st[0] = nloc; b.st[1] = nx; }
        const unsigned old = xb_add(&bar[XB_XSUB(b.x)], 1u);
        const unsigned gen = old / nloc;
        if (old + 1u == (gen + 1u) * nloc) {
            __builtin_amdgcn_fence(__ATOMIC_RELEASE, "agent");
            asm volatile("s_waitcnt vmcnt(0)" ::: "memory");
            const unsigned og = xb_add(&bar[XB_TOP], 1u);
            const unsigned tg = og / nx;
            if (og + 1u == (tg + 1u) * nx) xb_add(&bar[XB_TOPGEN], 1u);
            else XB_SPIN(xb_ld(&bar[XB_TOPGEN]) == tg, bar);
            __builtin_amdgcn_fence(__ATOMIC_ACQUIRE, "agent");
            xb_add(&bar[XB_XGEN(b.x)], 1u);
            asm volatile("s_waitcnt vmcnt(0)" ::: "memory");
        } else {
            XB_SPIN(xb_ld(&bar[XB_XGEN(b.x)]) == gen, bar);
            __builtin_amdgcn_fence(__ATOMIC_ACQUIRE, "agent");
            asm volatile("s_waitcnt vmcnt(0)" ::: "memory");
        }
    }
    __syncthreads();
}


#define TIDX (wave_s * 64 + pg8::lane_id())
#ifndef REP_BAR
#define REP_BAR 1
#endif
#define STAMP() do { } while (0)
#define GRID_BAR() do { for (int rb_ = 0; rb_ < REP_BAR; ++rb_) xcd_barrier(bar); STAMP(); } while (0)
template <int s>
__device__ __forceinline__ void fwd_step(const Args& args, LAS unsigned char* lds, const XcdBarrier& bar, const int wave_s, const int cidx  ) {
        const int layer = s / 3, k3 = s - 3 * layer;
        if (k3 != 1) {
            const int widx = layer * 2 + (k3 >> 1);
            {
                unsigned char* ws = opaque(args.ws); const int G = gridDim.x, bx = blockIdx.x;
                pg8::Gemm g{(const bf16*)(ws + WS_U), (const bf16*)(ws + WS_W1 + widx * SZ_W1), M, 2 * FF, D}; pg8::StaticOrder S; S.init(M, 2 * FF, G, cidx);
                const float* ssp = (const float*)(ws + WS_SS) + (size_t)s * M * 32; LAS float* rt = (LAS float*)(lds + 155712);
                pg8::Unit u0; S.next(0, u0);
                { const int t_ = TIDX; if (t_ < 256) { const f32x4* pp = (const f32x4*)(ssp + (size_t)(u0.pm * 256 + t_) * 32); f32x4 a = pp[0];
#pragma unroll
                    for (int k = 1; k < 8; ++k) a += pp[k];
                    rt[t_] = __builtin_amdgcn_rsqf(((a.x + a.y) + (a.z + a.w)) * (1.0f / 2048.0f) + 1e-6f); } }
                __syncthreads();
                pg8::EpiSwiglu E{(bf16*)(ws + WS_BIG), FF, ssp, u0.pm};
                for (int rep = 0; rep < REP_GEMM; ++rep) { if (rep > 0) GRID_BAR(); pg8::gemm_phase<pg8::EpiSwiglu, pg8::StaticOrder, true, true>(lds, g, S, E, wave_s); }
            }
            GRID_BAR();
            {
                unsigned char* ws = opaque(args.ws); const int G = gridDim.x, bx = blockIdx.x; float* out = opaque(args.out);
                pg8::Gemm g{(const bf16*)(ws + WS_BIG), (const bf16*)(ws + WS_W2 + widx * SZ_W2), M, D, FF}; pg8::StaticOrder S; S.init(M, D, G, cidx);
                pg8::EpiResid E{(bf16*)(ws + WS_U), (float*)(ws + WS_SS) + (size_t)(s + 1) * M * 32, D, 0.5f};
                pg8::gemm_phase<pg8::EpiResid, pg8::StaticOrder, true, true>(lds, g, S, E, wave_s);
            }
            GRID_BAR();
        } else {
            {
                unsigned char* ws = opaque(args.ws); const int G = gridDim.x, bx = blockIdx.x;
                pg8::Gemm g{(const bf16*)(ws + WS_U), (const bf16*)(ws + WS_WQKV + layer * SZ_WQKV), M, NQKV, D}; pg8::StaticOrder S; S.init(M, NQKV, G, cidx);
                const float* ssp = (const float*)(ws + WS_SS) + (size_t)s * M * 32; LAS float* rt = (LAS float*)(lds + 155712);
                pg8::Unit u0; S.next(0, u0);
                { const int t_ = TIDX; if (t_ < 256) { const f32x4* pp = (const f32x4*)(ssp + (size_t)(u0.pm * 256 + t_) * 32); f32x4 a = pp[0];
#pragma unroll
                    for (int k = 1; k < 8; ++k) a += pp[k];
                    rt[t_] = __builtin_amdgcn_rsqf(((a.x + a.y) + (a.z + a.w)) * (1.0f / 2048.0f) + 1e-6f); } }
                __syncthreads();
                pg8::EpiQkv E{(bf16*)(ws + WS_BIG), NQKV, ssp, u0.pm, (bf16*)(ws + WS_KT), layer == 0 ? 12 : 8};
                for (int rep = 0; rep < REP_GEMM; ++rep) { if (rep > 0) GRID_BAR(); pg8::gemm_phase<pg8::EpiQkv, pg8::StaticOrder, true, true>(lds, g, S, E, wave_s); }
            }
            GRID_BAR();
            if (layer == 0) {
                {
                    unsigned char* ws = opaque(args.ws); const int G = gridDim.x, bx = blockIdx.x;
                    const int tid = opaque_v(TIDX), lane = tid & 63, wave = __builtin_amdgcn_readfirstlane(tid >> 6);
                    const bf16* BIG = (const bf16*)(ws + WS_BIG); bf16* OB = (bf16*)(ws + WS_O); bf16* BR1 = (bf16*)opaque(args.out); bf16* BR2 = BR1 + (size_t)M * 1024;
                    float* LSE = (float*)(ws + WS_LSE); const float* BIAS = (const float*)(ws + WS_BIAS);
                    LAS float* btab = (LAS float*)(lds + 133120);
                    WCtx w; wctx_init(w, lds + wave * 8192, lane);
                    int cur_head = -1;
                    for (int rep = 0; rep < REP_DIL; ++rep)
                    for (int task = bx; task < 1536; task += G) {
                        {
                            const int ri = task >> 9, rem = task & 511, b = rem >> 7, head = (rem >> 4) & 7, grp = rem & 15;
                            const int r = ri == 0 ? 1 : (ri == 1 ? 4 : 16), sh = ri == 0 ? 7 : (ri == 1 ? 5 : 3), wt = grp * 8 + wave, c = wt >> sh, l0 = (wt - (c << sh)) * 32;
                            if (head != cur_head) {
                                __syncthreads();
                                for (int i = tid; i < 2112; i += NTHR) btab[i] = BIAS[head * 4096 + i];
                                __syncthreads();
                                cur_head = head; }
                            bf16* ob = ri == 0 ? OB : (ri == 1 ? BR1 : BR2);
                            dilated_wave(BIG, b, head, r, c, l0, ob, ri == 0 ? D : 1024, LSE + (size_t)ri * M * 8, btab, lds + 65536 + wave * 8448, w);
                        }
                    }
                    for (int wt = bx * NWAVES + wave; wt < 2048; wt += G * NWAVES) kmean_wave((const bf16*)(ws + WS_KT), (float*)(ws + WS_KMH), wt, lane);
                }
                GRID_BAR();
                {
                    unsigned char* ws = opaque(args.ws); const int G = gridDim.x, bx = blockIdx.x;
                    const int tid = opaque_v(TIDX), lane = tid & 63, wave = __builtin_amdgcn_readfirstlane(tid >> 6);
                    const bf16* BIG = (const bf16*)(ws + WS_BIG); bf16* OB = (bf16*)(ws + WS_O); bf16* BR1 = (bf16*)opaque(args.out); bf16* BR2 = BR1 + (size_t)M * 1024;
                    const float* BIAS = (const float*)(ws + WS_BIAS);
                    LAS float* btab = (LAS float*)(lds + 65536);
                    WCtx w; wctx_init(w, lds + wave * 8192, lane);
                    int cur_hh = -1;
                    for (int rep = 0; rep < REP_MOBA; ++rep)
                    for (int task = bx; task < 512; task += G) {
                        const int tt = task & 255, b = tt >> 6, hh = (tt >> 3) & 7, xx = tt & 7, own = task < 256 ? xx : 15 - xx;
                        if (hh != cur_hh) {
                            __syncthreads();
                            for (int i = tid; i < 4096; i += NTHR) btab[i] = BIAS[(8 + hh) * 4096 + i];
                            for (int i = tid; i < 1024; i += NTHR) ((LAS unsigned*)(lds + 81920))[i] = ((const unsigned*)(ws + WS_BKT))[i];
                            __syncthreads();
                            cur_hh = hh; }
                        moba_wg(BIG, (const bf16*)(ws + WS_KT), (const float*)(ws + WS_KMH), b, hh, own, wave, tid, OB, btab, (const LAS unsigned char*)(lds + 81920), lds, w);
                    }
                    const int gw = bx * NWAVES + wave, NGW = G * NWAVES;
                    for (int tok = gw; tok < M; tok += NGW) combine_wave(OB, BR1, BR2, (const float*)(ws + WS_LSE), tok, lane);
                }
                GRID_BAR();
            } else {
                {
                    unsigned char* ws = opaque(args.ws); const int G = gridDim.x, bx = blockIdx.x;
                    const int tid = opaque_v(TIDX), lane = tid & 63, wave = __builtin_amdgcn_readfirstlane(tid >> 6);
                    WCtx w; wctx_init(w, lds + wave * 8192, lane);
                    for (int rep = 0; rep < REP_SB; ++rep)
                    for (int task = bx; task < 1024; task += G) {
                        const int b = task >> 8, head = (task >> 4) & 15, qb = task & 15;
                        sb_wave((const bf16*)(ws + WS_BIG), (const bf16*)(ws + WS_KT), b, head, qb * 256 + wave * 32, (bf16*)(ws + WS_O), w);
                    }
                }
                GRID_BAR();
            }
            {
                unsigned char* ws = opaque(args.ws); const int G = gridDim.x, bx = blockIdx.x; float* out = opaque(args.out);
                pg8::Gemm g{(const bf16*)(ws + WS_O), (const bf16*)(ws + WS_WO + layer * SZ_WO), M, D, D}; pg8::StaticOrder S; S.init(M, D, G, cidx);
                pg8::EpiResid E{(bf16*)(ws + WS_U), (float*)(ws + WS_SS) + (size_t)(s + 1) * M * 32, D, 1.0f};
                pg8::gemm_phase<pg8::EpiResid, pg8::StaticOrder, true, true>(lds, g, S, E, wave_s);
            }
            GRID_BAR();
        }
}

__global__ void __launch_bounds__(NTHR, 2) fwd_megakernel(Args args) {
    cg::grid_group grid = cg::this_grid();
    LAS unsigned char* lds = (LAS unsigned char*)pg8::lds_raw;
    volatile LAS unsigned* bst = (volatile LAS unsigned*)(lds + 155648);
    if (threadIdx.x < 2) bst[threadIdx.x] = 0u;
    __syncthreads();
    const XcdBarrier bar = xcd_barrier_post((unsigned*)(args.ws + WS_CTL), bst);
    const int wave_s = bar.wv;
    unsigned* xcnt = (unsigned*)(args.ws + WS_CTL + 15360);
    if (TIDX == 0) bst[4] = __hip_atomic_fetch_add(xcnt + 16 * bar.x, 1u, __ATOMIC_RELAXED, __HIP_MEMORY_SCOPE_AGENT);

#ifndef REP_ALL
#define REP_ALL 1
#endif
    STAMP();
#pragma unroll 1
    for (int rep_all = 0; rep_all < REP_ALL; ++rep_all) {
    if (rep_all > 0) GRID_BAR();
    {
        const int tid = opaque_v(TIDX), lane = tid & 63, wave = __builtin_amdgcn_readfirstlane(tid >> 6);
        const int G = gridDim.x, bx = blockIdx.x, gw = bx * NWAVES + wave, NGW = G * NWAVES;
        for (int rep = 0; rep < REP_P0; ++rep)
        p0_weights(args, gw, NGW, lane);
        p0_bias(args, bx * NTHR + tid, G * NTHR);
        const float* x = as_global(args.in[0]); unsigned char* wsg = as_global(args.ws); bf16* HB = (bf16*)(wsg + WS_U); float* SS = (float*)(wsg + WS_SS);
        for (int mrow = gw; mrow < M; mrow += NGW) x_row(x + (size_t)mrow * D, HB + (size_t)mrow * D, SS + (size_t)mrow * 32, lane);
    }
    if (rep_all == 0) { grid.sync(); STAMP(); } else GRID_BAR();
    if (TIDX == 0) { bool even = (gridDim.x % 8u) == 0u;
        for (int j = 0; j < 8; ++j) even = even && (__hip_atomic_load(xcnt + 16 * j, __ATOMIC_RELAXED, __HIP_MEMORY_SCOPE_AGENT) == gridDim.x / 8u);
        bst[5] = (even && bar.x < 8u) ? (bst[4] * 8u + bar.x) : blockIdx.x; }
    __syncthreads();
    const int cidx = __builtin_amdgcn_readfirstlane((int)bst[5]);

    fwd_step<0>(args, lds, bar, wave_s, cidx); fwd_step<1>(args, lds, bar, wave_s, cidx); fwd_step<2>(args, lds, bar, wave_s, cidx);
    fwd_step<3>(args, lds, bar, wave_s, cidx); fwd_step<4>(args, lds, bar, wave_s, cidx); fwd_step<5>(args, lds, bar, wave_s, cidx);
    {
        unsigned char* ws = opaque(args.ws); float* out = opaque(args.out);
        const int tid = opaque_v(TIDX), lane = tid & 63, wave = __builtin_amdgcn_readfirstlane(tid >> 6);
        const int gw = blockIdx.x * NWAVES + wave, NGW = gridDim.x * NWAVES;
        const float* g = as_global(args.in[10]); const float* SS = (const float*)(ws + WS_SS) + (size_t)6 * M * 32;
        for (int mrow = gw; mrow < M; mrow += NGW) final_row(out + (size_t)mrow * D, (const bf16*)(ws + WS_U) + (size_t)mrow * D, g, SS + (size_t)mrow * 32, lane);
    }
    }
}

extern "C" void kernel_launch(void* const* d_in, const int* in_sizes, int n_in, void* d_out, int out_size, void* d_ws, size_t ws_size, hipStream_t stream) {
    static int grid = 0;
    if (grid == 0) {
        if (n_in != 11 || in_sizes[0] != M * D || out_size != M * D || ws_size < WS_END) {
            fprintf(stderr, "kernel_launch: shape/workspace mismatch (n_in %d, in0 %d, out %d, ws %zu, need %zu); nothing launched\n", n_in, n_in > 0 ? in_sizes[0] : -1, out_size, ws_size, (size_t)WS_END);
            grid = -1; return; }
        int dev = 0, cus = 0, per_cu = 0;
        (void)hipGetDevice(&dev); (void)hipDeviceGetAttribute(&cus, hipDeviceAttributeMultiprocessorCount, dev);
        if (hipFuncSetAttribute((const void*)fwd_megakernel, hipFuncAttributeMaxDynamicSharedMemorySize, LDS_BYTES) != hipSuccess) { fprintf(stderr, "kernel_launch: hipFuncSetAttribute failed\n"); grid = -1; return; }
        if (hipOccupancyMaxActiveBlocksPerMultiprocessor(&per_cu, (const void*)fwd_megakernel, NTHR, LDS_BYTES) != hipSuccess || per_cu < 1) { fprintf(stderr, "kernel_launch: occupancy query gave %d\n", per_cu); per_cu = 1; }
        (void)hipGetLastError();
        grid = cus * 1;
        if (grid > 256) grid = 256;
        if (grid != 256) { fprintf(stderr, "kernel_launch: built for a 256-CU MI355X (the GEMM epilogues rely on the 256-workgroup unit order); device has %d CUs; nothing launched\n", cus); grid = -1; return; }
    }
    if (grid < 0) return;
    if (hipMemsetAsync((char*)d_ws + WS_CTL, 0, CTL_BYTES, stream) != hipSuccess) { fprintf(stderr, "kernel_launch: memset of the barrier words failed\n"); return; }
    Args a{};
    for (int i = 0; i < 11; ++i) a.in[i] = (const float*)d_in[i];
    a.out = (float*)d_out; a.ws = (unsigned char*)d_ws;
    void* kargs[] = {&a};
    hipError_t e = hipLaunchCooperativeKernel((const void*)fwd_megakernel, dim3(grid), dim3(NTHR), kargs, LDS_BYTES, stream);
    if (e != hipSuccess) fprintf(stderr, "kernel_launch: cooperative launch failed: %s (grid %d)\n", hipGetErrorString(e), grid);
}
```

```cpp
#include <hip/hip_runtime.h>
#include <hip/hip_cooperative_groups.h>
#include <cstdio>
#include <cstdint>
namespace cg = cooperative_groups;
namespace pg8 {
#define PG8_LAS __attribute__((address_space(3)))
extern __shared__ __attribute__((aligned(16))) unsigned char lds_raw[];
__device__ __forceinline__ int lane_id() { return (int)__builtin_amdgcn_mbcnt_hi(~0u, __builtin_amdgcn_mbcnt_lo(~0u, 0u)); }
typedef unsigned short bf16_t;
typedef short bf16x8 __attribute__((ext_vector_type(8)));
typedef float f32x4 __attribute__((ext_vector_type(4)));
typedef unsigned u32x4 __attribute__((ext_vector_type(4)));
constexpr int BM = 256, BK = 64, HALF = 128, HTB = HALF * BK * 2  , STAGE_BYTES = 8 * HTB, NXCD = 8, WGM = 8;

__host__ __device__ __forceinline__ int lds_byte(int r, int c) { const int st = (r >> 4) * 2 + (c >> 5), rr = r & 15, cc = c & 31, ob = rr * 64 + cc * 2; return st * 1024 + (ob ^ (((ob >> 9) & 1) << 5)); }
__host__ __device__ __forceinline__ void stage_rc(int b, int& R, int& C) { const int st = b / 1024, sb = b % 1024, swz = sb ^ (((sb >> 9) & 1) << 5); R = (st >> 1) * 16 + swz / 64; C = (st & 1) * 32 + (swz % 64) / 2; }
__host__ __device__ __forceinline__ int perm32(int rho) { const int n = rho >> 4, i = rho & 15; return 8 * (i >> 2) + 4 * n + (i & 3); }

struct Unit { int pm, pn; };
struct Gemm { const bf16_t* A; const bf16_t* Bt; int M, N, K; };

struct StaticOrder {
    int nM, nN, nwg, G, c;
    __host__ __device__ void init(int M, int N, int G_, int c_) { nM = M / BM; nN = N / BM; nwg = nM * nN; G = G_; c = c_; }
    __host__ __device__ bool next(int i, Unit& u) const {
        const long L = (long)i * G + c; if (L >= nwg) return false;
        int wgid = (int)L; { const int q = nwg / NXCD, r = nwg % NXCD, xcd = wgid % NXCD, off = wgid / NXCD; wgid = (xcd < r ? xcd * (q + 1) : r * (q + 1) + (xcd - r) * q) + off; }
        const int nig = WGM * nN, gid = wgid / nig, fm = gid * WGM, gsz = (nM - fm) < WGM ? (nM - fm) : WGM;
        u.pm = fm + ((wgid % nig) % gsz); u.pn = (wgid % nig) / gsz; return true;
    }
    __device__ __forceinline__ void a_ready(const Unit&) const {}
    __device__ __forceinline__ void done(const Unit&) const {}
};

__device__ __forceinline__ unsigned cvt_pk_bf16(float lo, float hi) { unsigned r; asm volatile("v_cvt_pk_bf16_f32 %0, %1, %2" : "=v"(r) : "v"(lo), "v"(hi)); return r; }
typedef float f32x2 __attribute__((ext_vector_type(2)));
__device__ __forceinline__ f32x2 gelu_pk(f32x2 v) {
    const f32x2 av = __builtin_elementwise_abs(v), d = av * 0.2316418882f + 1.0f;
    f32x2 t; t.x = __builtin_amdgcn_rcpf(d.x); t.y = __builtin_amdgcn_rcpf(d.y);
    f32x2 q = t * 0.5307027145f + (-0.7265760135f); q = q * t + 0.7107068705f; q = q * t + (-0.142248368f); q = q * t + 0.127414796f; q = q * t;
    const f32x2 s = (v * v) * (-0.72134752044f);
    f32x2 e; e.x = __builtin_amdgcn_exp2f(s.x); e.y = __builtin_amdgcn_exp2f(s.y);
    const f32x2 m = v * (q * e), r = v - m;
    f32x2 o; o.x = v.x < 0.f ? m.x : r.x; o.y = v.y < 0.f ? m.y : r.y; return o;
}

template <int ACT  > struct EpiBf16 {
    static constexpr bool PERM = true, AFTER_DRAIN = false; static_assert(ACT == 0 || ACT == 1, "EpiBf16: ACT is 0 (none) or 1 (gelu_pk)");
    bf16_t* O; int ldc; const float* bias; int split_cols; size_t split_stride; float scale0;
    __device__ __forceinline__ void operator()(const f32x4 (&acc)[2][2][4][2], const Unit& u, int wr, int wc, int fr, int fq) const {
        const int row0 = u.pm * BM + wr * 64 + fr; int colt = u.pn * BM; bf16_t* base = O;
        float sc = 1.f; if (split_cols) { const int t = colt / split_cols; base += (size_t)t * split_stride; colt -= t * split_cols; if (t == 0) sc = scale0; }
        const int col0 = colt + wc * 32 + 8 * fq, bcol0 = u.pn * BM + wc * 32 + 8 * fq;
        f32x4 bv[2][2];
#pragma unroll
        for (int bj = 0; bj < 2; ++bj)
#pragma unroll
            for (int n = 0; n < 2; ++n) bv[bj][n] = bias ? *(const f32x4*)(bias + bcol0 + bj * HALF + 4 * n) : (f32x4){0.f, 0.f, 0.f, 0.f};
#pragma unroll
        for (int ai = 0; ai < 2; ++ai)
#pragma unroll
            for (int m = 0; m < 4; ++m) { bf16_t* rowp = base + (size_t)(row0 + ai * HALF + m * 16) * ldc + col0;
#pragma unroll
                for (int bj = 0; bj < 2; ++bj) { f32x4 v0 = acc[ai][bj][m][0] + bv[bj][0], v1 = acc[ai][bj][m][1] + bv[bj][1];
                    if (ACT == 1) { f32x2 a = gelu_pk((f32x2){v0[0], v0[1]}), b = gelu_pk((f32x2){v0[2], v0[3]}), c = gelu_pk((f32x2){v1[0], v1[1]}), d = gelu_pk((f32x2){v1[2], v1[3]});
                        v0 = (f32x4){a.x, a.y, b.x, b.y}; v1 = (f32x4){c.x, c.y, d.x, d.y}; }
                    v0 = v0 * sc; v1 = v1 * sc; u32x4 w; w.x = cvt_pk_bf16(v0[0], v0[1]); w.y = cvt_pk_bf16(v0[2], v0[3]); w.z = cvt_pk_bf16(v1[0], v1[1]); w.w = cvt_pk_bf16(v1[2], v1[3]);
                    *(u32x4*)(rowp + bj * HALF) = w; } }
    }
};
__device__ __forceinline__ void load_rstd8_lds(const PG8_LAS float* rt, int rloc, float (&rs)[2][4]) {
#pragma unroll
    for (int ai = 0; ai < 2; ++ai)
#pragma unroll
        for (int m = 0; m < 4; ++m) rs[ai][m] = rt[rloc + ai * HALF + m * 16];
}
__device__ __forceinline__ void load_rstd8(const float* ss, int row0, float (&rs)[2][4]) {
    float v[2][4];
#pragma unroll
    for (int ai = 0; ai < 2; ++ai)
#pragma unroll
        for (int m = 0; m < 4; ++m) v[ai][m] = ss[row0 + ai * HALF + m * 16];
#pragma unroll
    for (int ai = 0; ai < 2; ++ai)
#pragma unroll
        for (int m = 0; m < 4; ++m) rs[ai][m] = __builtin_amdgcn_rsqf(v[ai][m] * (1.0f / 2048.0f) + 1e-6f);
}
struct EpiSwiglu {
    static constexpr bool PERM = true, AFTER_DRAIN = false;
    bf16_t* O; int ldc; const float* ss; int pm0;
    __device__ __forceinline__ void operator()(const f32x4 (&acc)[2][2][4][2], const Unit& u, int wr, int wc, int fr, int fq) const {
        const int row0 = u.pm * BM + wr * 64 + fr, col0 = u.pn * HALF + wc * 32 + 8 * fq;
        float rsv[2][4]; load_rstd8_lds((const PG8_LAS float*)((PG8_LAS unsigned char*)lds_raw + 155712), wr * 64 + fr, rsv);
#pragma unroll
        for (int ai = 0; ai < 2; ++ai)
#pragma unroll
            for (int m = 0; m < 4; ++m) {
                const int row = row0 + ai * HALF + m * 16; bf16_t* rowp = O + (size_t)row * ldc + col0;
                const float rs = rsv[ai][m];
                float r[8];
#pragma unroll
                for (int n = 0; n < 2; ++n)
#pragma unroll
                    for (int e = 0; e < 4; ++e) { const float g = acc[ai][0][m][n][e] * rs, up = acc[ai][1][m][n][e] * rs;
                        const float sg = g * __builtin_amdgcn_rcpf(1.0f + __builtin_amdgcn_exp2f(-1.44269504089f * g)); r[4 * n + e] = sg * up; }
                u32x4 w; w.x = cvt_pk_bf16(r[0], r[1]); w.y = cvt_pk_bf16(r[2], r[3]); w.z = cvt_pk_bf16(r[4], r[5]); w.w = cvt_pk_bf16(r[6], r[7]);
                *(u32x4*)rowp = w; }
    }
};
struct EpiResid {
    static constexpr bool PERM = true, AFTER_DRAIN = false;
    bf16_t* hi; float* ss; int ldc; float scale;
    __device__ __forceinline__ void operator()(const f32x4 (&acc)[2][2][4][2], const Unit& u, int wr, int wc, int fr, int fq) const {
        const int row0 = u.pm * BM + wr * 64 + fr, col0 = u.pn * BM + wc * 32 + 8 * fq;
#pragma unroll
        for (int ai = 0; ai < 2; ++ai)
#pragma unroll
            for (int m = 0; m < 4; ++m) { const int row = row0 + ai * HALF + m * 16; const size_t off = (size_t)row * ldc + col0; float q = 0.f;
#pragma unroll
                for (int bj = 0; bj < 2; ++bj) { const size_t ix = off + bj * HALF;
                    const u32x4 xh = *(const u32x4*)(hi + ix);
                    u32x4 wh;
#pragma unroll
                    for (int e = 0; e < 4; ++e) {
                        const float a = acc[ai][bj][m][e >> 1][2 * (e & 1)], b = acc[ai][bj][m][e >> 1][2 * (e & 1) + 1];
                        const float o0 = __uint_as_float(xh[e] << 16) + a * scale, o1 = __uint_as_float(xh[e] & 0xffff0000u) + b * scale;
                        const unsigned h2 = cvt_pk_bf16(o0, o1); wh[e] = h2;
                        const float r0 = __uint_as_float(h2 << 16), r1 = __uint_as_float(h2 & 0xffff0000u);
                        q += r0 * r0 + r1 * r1; }
                    *(u32x4*)(hi + ix) = wh; }
                q += __shfl_xor(q, 16); q += __shfl_xor(q, 32);
                if (fq == 0) ss[(size_t)row * 32 + u.pn * 4 + wc] = q;
                }
    }
};
struct EpiQkv {
    static constexpr bool PERM = true, AFTER_DRAIN = false;
    bf16_t* O; int ldc; const float* ss; int pm0; bf16_t* KT; int kt_lo;
    __device__ __forceinline__ void operator()(const f32x4 (&acc)[2][2][4][2], const Unit& u, int wr, int wc, int fr, int fq) const {
        const int row0 = u.pm * BM + wr * 64 + fr, col0 = u.pn * BM + wc * 32 + 8 * fq;
        float rsv[2][4]; load_rstd8_lds((const PG8_LAS float*)((PG8_LAS unsigned char*)lds_raw + 155712), wr * 64 + fr, rsv);
        if (u.pn >= kt_lo && u.pn < 16) {
#pragma unroll
            for (int ai = 0; ai < 2; ++ai)
#pragma unroll
                for (int m = 0; m < 4; ++m) { const int row = row0 + ai * HALF + m * 16;
                    const float rs = rsv[ai][m];
                    const int b = row >> 12, key = row & 4095;
#pragma unroll
                    for (int bj = 0; bj < 2; ++bj) { const int head = (u.pn - 8) * 2 + bj;
                        bf16_t* p = KT + ((size_t)((b * 16 + head) * 128 + (key >> 5)) << 12) + (wc * 2 + (fq >> 1)) * 512 + ((fq & 1) * 32 + (key & 31)) * 8;
                        const f32x4 v0 = acc[ai][bj][m][0] * rs, v1 = acc[ai][bj][m][1] * rs;
                        u32x4 w; w.x = cvt_pk_bf16(v0[0], v0[1]); w.y = cvt_pk_bf16(v0[2], v0[3]); w.z = cvt_pk_bf16(v1[0], v1[1]); w.w = cvt_pk_bf16(v1[2], v1[3]);
                        *(u32x4*)p = w; } }
            return; }
#pragma unroll
        for (int ai = 0; ai < 2; ++ai)
#pragma unroll
            for (int m = 0; m < 4; ++m) { const int row = row0 + ai * HALF + m * 16;
                const float rs = rsv[ai][m];
                bf16_t* rowp = O + (size_t)row * ldc + col0;
#pragma unroll
                for (int bj = 0; bj < 2; ++bj) { const f32x4 v0 = acc[ai][bj][m][0] * rs, v1 = acc[ai][bj][m][1] * rs;
                    u32x4 w; w.x = cvt_pk_bf16(v0[0], v0[1]); w.y = cvt_pk_bf16(v0[2], v0[3]); w.z = cvt_pk_bf16(v1[0], v1[1]); w.w = cvt_pk_bf16(v1[2], v1[3]);
                    *(u32x4*)(rowp + bj * HALF) = w; } }
    }
};
template <class Epi, class Sched, bool ALIGN_EPI = false, bool SP2 = false>
__device__ __forceinline__ void gemm_phase(PG8_LAS unsigned char* lds, const Gemm g, const Sched& S, const Epi& E, int wave_s  ) {
    int tid_ = wave_s * 64 + lane_id(); asm volatile("" : "+v"(tid_));
    const int tid = tid_, wid = __builtin_amdgcn_readfirstlane(tid >> 6), lane = tid & 63, wr = wid >> 2, wc = wid & 3, fr = lane & 15, fq = lane >> 4;
    const int K = g.K, nt = K / BK;
    unsigned voffA[2], voffB[2];
#pragma unroll
    for (int i = 0; i < 2; ++i) { int R, C; stage_rc(tid * 16 + i * 8192, R, C); const int Rb = Epi::PERM ? ((R & ~31) + perm32(R & 31)) : R;
        voffA[i] = (unsigned)(R * K + C) * 2u; voffB[i] = (unsigned)(Rb * K + C) * 2u; }
    const size_t kstep = (size_t)(BK * 2);
    const size_t hstep = (size_t)HALF * K * 2;
    const size_t tstep = 2 * hstep;
    const unsigned ldsw = (unsigned)wid * 1024u;
    const int aoff = lds_byte(wr * 64 + fr, fq * 8), boff = lds_byte(wc * 32 + fr, fq * 8);
#define PG8_SA(b, h) (((b) * 2 + (h)) * HTB)
#define PG8_SB(b, h) ((4 + (b) * 2 + (h)) * HTB)
#define PG8_STAGE(bufoff, gbase, voff) do { _Pragma("unroll") for (int _i = 0; _i < 2; ++_i) \
        __builtin_amdgcn_global_load_lds((const unsigned*)((const char*)(gbase) + (voff)[_i]), (PG8_LAS unsigned*)(lds + (bufoff) + ldsw + _i * 8192), 16, 0, 0); } while (0)
#define PG8_LDA(dst, b, h) do { _Pragma("unroll") for (int m = 0; m < 4; ++m) _Pragma("unroll") for (int k = 0; k < 2; ++k) dst[m][k] = *(const PG8_LAS bf16x8*)(lds + PG8_SA(b, h) + aoff + m * 2048 + k * 1024); } while (0)
#define PG8_LDB(dst, b, h) do { _Pragma("unroll") for (int n = 0; n < 2; ++n) _Pragma("unroll") for (int k = 0; k < 2; ++k) dst[n][k] = *(const PG8_LAS bf16x8*)(lds + PG8_SB(b, h) + boff + n * 2048 + k * 1024); } while (0)
#define PG8_MMA(ai, bj, At, Bt) do { __builtin_amdgcn_s_setprio(1); _Pragma("unroll") for (int m = 0; m < 4; ++m) _Pragma("unroll") for (int n = 0; n < 2; ++n) _Pragma("unroll") for (int k = 0; k < 2; ++k) \
        acc[ai][bj][m][n] = __builtin_amdgcn_mfma_f32_16x16x32_bf16(Bt[n][k], At[m][k], acc[ai][bj][m][n], 0, 0, 0); __builtin_amdgcn_s_setprio(0); } while (0)
#define PG8_WAIT_V(n) asm volatile("s_waitcnt vmcnt(" #n ")" ::: "memory")
#define PG8_WAIT_L(n) asm volatile("s_waitcnt lgkmcnt(" #n ")" ::: "memory")
#define PG8_BAR __builtin_amdgcn_s_barrier()
#define PG8_SCHED __builtin_amdgcn_sched_barrier(0)
    Unit cur, nxt; int ui = 0;
    if (!S.next(0, cur)) return;
    f32x4 acc[2][2][4][2];
#pragma unroll
    for (int a = 0; a < 2; ++a)
#pragma unroll
        for (int b = 0; b < 2; ++b)
#pragma unroll
            for (int m = 0; m < 4; ++m)
#pragma unroll
                for (int n = 0; n < 2; ++n) acc[a][b][m][n] = (f32x4){0.f, 0.f, 0.f, 0.f};
    bf16x8 At[4][2], B0[2][2], B1[2][2];
    const char* cA = (const char*)g.A + (size_t)cur.pm * tstep; const char* cB = (const char*)g.Bt + (size_t)cur.pn * tstep;
    S.a_ready(cur);
    if constexpr (SP2) {
        PG8_STAGE(PG8_SB(0, 0), cB, voffB); PG8_STAGE(PG8_SB(0, 1), cB + hstep, voffB); PG8_STAGE(PG8_SA(0, 0), cA, voffA); PG8_STAGE(PG8_SA(0, 1), cA + hstep, voffA);
        if (wr == 1) PG8_BAR;
        PG8_WAIT_V(2); PG8_BAR;
        PG8_STAGE(PG8_SB(1, 0), cB + kstep, voffB); PG8_STAGE(PG8_SA(1, 0), cA + kstep, voffA); PG8_STAGE(PG8_SB(1, 1), cB + hstep + kstep, voffB);
        PG8_WAIT_V(6); PG8_BAR;
    } else {
        PG8_STAGE(PG8_SB(0, 0), cB, voffB); PG8_STAGE(PG8_SA(0, 0), cA, voffA); PG8_STAGE(PG8_SB(0, 1), cB + hstep, voffB); PG8_STAGE(PG8_SA(0, 1), cA + hstep, voffA);
        if (wr == 1) PG8_BAR;
        PG8_WAIT_V(4); PG8_BAR;
        PG8_STAGE(PG8_SB(1, 0), cB + kstep, voffB); PG8_STAGE(PG8_SA(1, 0), cA + kstep, voffA); PG8_STAGE(PG8_SB(1, 1), cB + hstep + kstep, voffB);
        PG8_WAIT_V(6); PG8_BAR;
    }
    for (;;) {
        const bool has_next = S.next(ui + 1, nxt);
        const char* nA = has_next ? (const char*)g.A + (size_t)nxt.pm * tstep : cA; const char* nB = has_next ? (const char*)g.Bt + (size_t)nxt.pn * tstep : cB;
        for (int t = 0; t < nt; t += 2) {
            const bool last = (t == nt - 2);
            const char* a1 = cA + (size_t)(t + 1) * kstep;
            const char* a2 = last ? nA : cA + (size_t)(t + 2) * kstep; const char* b2 = last ? nB : cB + (size_t)(t + 2) * kstep;
            const char* a3 = a2 + kstep; const char* b3 = b2 + kstep;
            if (last && has_next) S.a_ready(nxt);
            if constexpr (SP2) {
            PG8_LDB(B0, 0, 0); PG8_LDB(B1, 0, 1); PG8_SCHED; PG8_LDA(At, 0, 0); PG8_STAGE(PG8_SA(1, 1), a1 + hstep, voffA);
            PG8_WAIT_V(8); PG8_WAIT_L(0); PG8_BAR; PG8_MMA(0, 0, At, B0); PG8_MMA(0, 1, At, B1); PG8_BAR; PG8_SCHED;
            PG8_LDA(At, 0, 1); PG8_STAGE(PG8_SB(0, 0), b2, voffB); PG8_STAGE(PG8_SB(0, 1), b2 + hstep, voffB); PG8_STAGE(PG8_SA(0, 0), a2, voffA);
            PG8_WAIT_V(8); PG8_WAIT_L(0); PG8_BAR; PG8_MMA(1, 0, At, B0); PG8_MMA(1, 1, At, B1); PG8_BAR; PG8_SCHED;
            PG8_LDB(B0, 1, 0); PG8_LDB(B1, 1, 1); PG8_SCHED; PG8_LDA(At, 1, 0); PG8_STAGE(PG8_SA(0, 1), a2 + hstep, voffA);
            PG8_WAIT_V(8); PG8_WAIT_L(0); PG8_BAR; PG8_MMA(0, 0, At, B0); PG8_MMA(0, 1, At, B1); PG8_BAR; PG8_SCHED;
            PG8_LDA(At, 1, 1); PG8_STAGE(PG8_SB(1, 0), b3, voffB); PG8_STAGE(PG8_SB(1, 1), b3 + hstep, voffB); PG8_STAGE(PG8_SA(1, 0), a3, voffA);
            PG8_WAIT_V(8); PG8_WAIT_L(0); PG8_BAR; PG8_MMA(1, 0, At, B0); PG8_MMA(1, 1, At, B1); PG8_BAR; PG8_SCHED;
            } else {
            PG8_LDB(B0, 0, 0); PG8_SCHED; PG8_LDA(At, 0, 0); PG8_STAGE(PG8_SA(1, 1), a1 + hstep, voffA);
            PG8_WAIT_L(8); PG8_BAR; PG8_WAIT_L(0); PG8_MMA(0, 0, At, B0); PG8_BAR; PG8_SCHED;
            PG8_LDB(B1, 0, 1); PG8_STAGE(PG8_SB(0, 0), b2, voffB);
            PG8_BAR; PG8_WAIT_L(0); PG8_MMA(0, 1, At, B1); PG8_BAR;
            PG8_LDA(At, 0, 1); PG8_STAGE(PG8_SA(0, 0), a2, voffA);
            PG8_BAR; PG8_WAIT_L(0); PG8_MMA(1, 0, At, B0); PG8_BAR; PG8_SCHED;
            PG8_STAGE(PG8_SB(0, 1), b2 + hstep, voffB);
            PG8_WAIT_V(6); PG8_BAR; PG8_MMA(1, 1, At, B1); PG8_BAR;
            PG8_LDB(B0, 1, 0); PG8_SCHED; PG8_LDA(At, 1, 0); PG8_STAGE(PG8_SA(0, 1), a2 + hstep, voffA);
            PG8_WAIT_L(8); PG8_BAR; PG8_WAIT_L(0); PG8_MMA(0, 0, At, B0); PG8_BAR; PG8_SCHED;
            PG8_LDB(B1, 1, 1); PG8_STAGE(PG8_SB(1, 0), b3, voffB);
            PG8_BAR; PG8_WAIT_L(0); PG8_MMA(0, 1, At, B1); PG8_BAR;
            PG8_LDA(At, 1, 1); PG8_STAGE(PG8_SA(1, 0), a3, voffA);
            PG8_BAR; PG8_WAIT_L(0); PG8_MMA(1, 0, At, B0); PG8_BAR; PG8_SCHED;
            PG8_STAGE(PG8_SB(1, 1), b3 + hstep, voffB);
            PG8_WAIT_V(6); PG8_BAR; PG8_MMA(1, 1, At, B1); PG8_BAR;
            }
        }
        if constexpr (ALIGN_EPI) { if (wr == 0) PG8_BAR; }
        if constexpr (!Epi::AFTER_DRAIN) { E(acc, cur, wr, wc, fr, fq); S.done(cur); }
        if (!has_next) break;
#pragma unroll
        for (int a = 0; a < 2; ++a)
#pragma unroll
            for (int b = 0; b < 2; ++b)
#pragma unroll
                for (int m = 0; m < 4; ++m)
#pragma unroll
                    for (int n = 0; n < 2; ++n) acc[a][b][m][n] = (f32x4){0.f, 0.f, 0.f, 0.f};
        cur = nxt; cA = nA; cB = nB; ++ui;
        if constexpr (ALIGN_EPI) { if (wr == 1) PG8_BAR; }
    }
    PG8_WAIT_V(0);
    if constexpr (!ALIGN_EPI) { if (wr == 0) PG8_BAR; }
    PG8_BAR;
    if constexpr (Epi::AFTER_DRAIN) { E.fused(acc, cur, wr, wc, fr, fq, lds, wid, lane); S.done(cur); }
#undef PG8_SA
#undef PG8_SB
#undef PG8_STAGE
#undef PG8_LDA
#undef PG8_LDB
#undef PG8_MMA
#undef PG8_WAIT_V
#undef PG8_WAIT_L
#undef PG8_BAR
#undef PG8_SCHED
}
}

#define LAS __attribute__((address_space(3)))
typedef unsigned short bf16;
typedef float f32x4 __attribute__((ext_vector_type(4)));
typedef float f32x16 __attribute__((ext_vector_type(16)));
typedef short bf16x8 __attribute__((ext_vector_type(8)));
typedef short s16x4 __attribute__((ext_vector_type(4)));
typedef unsigned u32x2 __attribute__((ext_vector_type(2)));
typedef unsigned u32x4 __attribute__((ext_vector_type(4)));

constexpr int NWAVES = 8, NTHR = 512;
constexpr int BATCH = 4, SEQ = 4096, D = 2048, M = BATCH * SEQ, FF = 5632, NH = 16, HD = 128, NQKV = 3 * D;
constexpr float RMS_EPS = 1e-6f;
constexpr float LOG2E = 1.44269504089f;
constexpr float SC2 = 0.08838834764831845f * LOG2E;

constexpr size_t SZ_W1 = (size_t)2 * FF * D * 2, SZ_W2 = (size_t)D * FF * 2, SZ_WQKV = (size_t)NQKV * D * 2, SZ_WO = (size_t)D * D * 2;
constexpr size_t WS_W1 = 0, WS_W2 = WS_W1 + 4 * SZ_W1, WS_WQKV = WS_W2 + 4 * SZ_W2, WS_WO = WS_WQKV + 2 * SZ_WQKV;
constexpr size_t WS_U = WS_WO + 2 * SZ_WO;
constexpr size_t WS_BIG = WS_U + (size_t)M * D * 2;
constexpr size_t WS_O = WS_BIG + (size_t)M * NQKV * 2;
constexpr size_t WS_LSE = WS_O + (size_t)M * D * 2;
constexpr size_t WS_KMH = WS_LSE + (size_t)3 * M * 8 * 4;
constexpr size_t WS_KML = WS_KMH + (size_t)4 * BATCH * 8 * 16 * 128 * 4;
constexpr size_t WS_BIAS = WS_KML + (size_t)BATCH * 8 * 16 * 128 * 2;
constexpr size_t WS_BKT = WS_BIAS + (size_t)16 * 4096 * 4;
constexpr size_t WS_SS = WS_BKT + 4096;
constexpr size_t WS_KT = WS_SS + (size_t)7 * M * 32 * 4;
constexpr size_t WS_CTL = WS_KT + (size_t)M * D * 2;
constexpr size_t CTL_BYTES = 16384;
constexpr size_t WS_END = WS_CTL + CTL_BYTES;

constexpr int LDS_BYTES = 155648 + 64 + 1024;
#ifndef REP_GEMM
#define REP_GEMM 1
#endif
#ifndef REP_P0
#define REP_P0 1
#endif
#ifndef REP_NORM
#define REP_NORM 1
#endif
#ifndef REP_DIL
#define REP_DIL 1
#endif
#ifndef REP_MOBA
#define REP_MOBA 1
#endif
#ifndef REP_SB
#define REP_SB 1
#endif

struct Args { const float* in[11]; float* out; unsigned char* ws; };

__device__ __forceinline__ float wave_sum(float v) {
#pragma unroll
    for (int o = 1; o < 64; o <<= 1) v += __shfl_xor(v, o);
    return v;
}
__device__ __forceinline__ unsigned cvtpk(float lo, float hi) { return pg8::cvt_pk_bf16(lo, hi); }
template <class T> __device__ __forceinline__ T* as_global(T* p) { return (T*)(__attribute__((address_space(1))) T*)p; }

__device__ __forceinline__ void tr_item(const float* __restrict__ W, int N, bf16* __restrict__ WT, int K, int k0, int n0, int drow0, int lane, const float* __restrict__ gain) {
    const int c = lane & 7, n4 = lane >> 3;
    const float* src = W + (size_t)(k0 + 8 * c) * N + n0 + 4 * n4;
    f32x4 v[8];
#pragma unroll
    for (int j = 0; j < 8; ++j) v[j] = __builtin_nontemporal_load((const f32x4*)(src + (size_t)j * N));
    if (gain) {
        const f32x4 g0 = *(const f32x4*)(gain + k0 + 8 * c), g1 = *(const f32x4*)(gain + k0 + 8 * c + 4);
        v[0] *= g0[0]; v[1] *= g0[1]; v[2] *= g0[2]; v[3] *= g0[3]; v[4] *= g1[0]; v[5] *= g1[1]; v[6] *= g1[2]; v[7] *= g1[3]; }
    bf16* dst = WT + (size_t)(drow0 + 4 * n4) * K + k0 + 8 * c;
#pragma unroll
    for (int e = 0; e < 4; ++e) {
        u32x4 o; o.x = cvtpk(v[0][e], v[1][e]); o.y = cvtpk(v[2][e], v[3][e]); o.z = cvtpk(v[4][e], v[5][e]); o.w = cvtpk(v[6][e], v[7][e]);
        *(u32x4*)(dst + (size_t)e * K) = o; }
}
__device__ __forceinline__ void p0_weights(const Args& a, int gw, int NGW, int lane) {
    constexpr int I_F = (D / 64) * (FF / 32);
    constexpr int I_Q = (D / 64) * (NQKV / 32);
    constexpr int I_O = (D / 64) * (D / 32);
    constexpr int NITEMS = 12 * I_F + 2 * I_Q + 2 * I_O;
    unsigned char* ws = as_global(a.ws);
    for (int it = gw; it < NITEMS; it += NGW) {
        if (it < 12 * I_F) {
            const int seg = it / I_F, r = it - seg * I_F, kind = seg >> 2, idx = seg & 3;
            if (kind < 2) {
                const float* W = as_global(a.in[2 + kind]) + (size_t)idx * D * FF;
                const int nnb = FF / 32, kb = r / nnb, nb = r - kb * nnb, n0 = nb * 32;
                tr_item(W, FF, (bf16*)(ws + WS_W1 + idx * SZ_W1), D, kb * 64, n0, (n0 >> 7) * 256 + kind * 128 + (n0 & 127), lane, as_global(a.in[1]) + (size_t)((idx >> 1) * 3 + (idx & 1) * 2) * D);
            } else {
                const float* W = as_global(a.in[4]) + (size_t)idx * FF * D;
                const int nnb = D / 32, kb = r / nnb, nb = r - kb * nnb, n0 = nb * 32;
                tr_item(W, D, (bf16*)(ws + WS_W2 + idx * SZ_W2), FF, kb * 64, n0, n0, lane, nullptr);
            }
        } else {
            int r = it - 12 * I_F;
            if (r < 2 * I_Q) { const int l = r / I_Q; r -= l * I_Q; const float* W = as_global(a.in[l == 0 ? 5 : 7]);
                const int nnb = NQKV / 32, kb = r / nnb, nb = r - kb * nnb, n0 = nb * 32;
                tr_item(W, NQKV, (bf16*)(ws + WS_WQKV + l * SZ_WQKV), D, kb * 64, n0, n0, lane, as_global(a.in[1]) + (size_t)(l * 3 + 1) * D);
            } else { r -= 2 * I_Q; const int l = r / I_O; r -= l * I_O; const float* W = as_global(a.in[l == 0 ? 6 : 8]);
                const int nnb = D / 32, kb = r / nnb, nb = r - kb * nnb, n0 = nb * 32;
                tr_item(W, D, (bf16*)(ws + WS_WO + l * SZ_WO), D, kb * 64, n0, n0, lane, nullptr);
            }
        }
    }
}
__device__ __forceinline__ void p0_bias(const Args& a, int gtid, int gthreads) {
    float* bt = (float*)(as_global(a.ws) + WS_BIAS); const float* rb = as_global(a.in[9]);
    for (int i = gtid; i < 16 * 4096; i += gthreads) {
        const int h = i >> 12, d = i & 4095; int bk;
        if (d < 16) bk = d; else { const float df = (float)d; int lg = 16 + (int)(logf(df / 16.0f) / logf(128.0f) * 16.0f); bk = lg < 31 ? lg : 31; }
        bt[i] = rb[bk * 16 + h] * LOG2E;
        if (h == 0) (as_global(a.ws) + WS_BKT)[d] = (unsigned char)bk;
    }
}
template <bool TO_F32>
__device__ __forceinline__ void rms_row(const float* xrow, const float* g, void* orow, int lane) {
    const f32x4* xr = (const f32x4*)xrow + lane; const f32x4* gr = (const f32x4*)g + lane;
    f32x4 v[8]; float s = 0.f;
#pragma unroll
    for (int j = 0; j < 8; ++j) { v[j] = xr[64 * j]; s += (v[j].x * v[j].x + v[j].y * v[j].y) + (v[j].z * v[j].z + v[j].w * v[j].w); }
    const float rstd = 1.0f / sqrtf(wave_sum(s) * (1.0f / D) + RMS_EPS);
#pragma unroll
    for (int j = 0; j < 8; ++j) { const f32x4 gg = gr[64 * j]; const f32x4 y = v[j] * rstd * gg;
        if (TO_F32) ((f32x4*)orow)[lane + 64 * j] = y;
        else { u32x2 w; w.x = cvtpk(y.x, y.y); w.y = cvtpk(y.z, y.w); ((u32x2*)orow)[lane + 64 * j] = w; } }
}

__device__ __forceinline__ void x_row(const float* xrow, bf16* orow, float* ss, int lane) {
    const f32x4* xr = (const f32x4*)xrow + lane; float s = 0.f;
#pragma unroll
    for (int j = 0; j < 8; ++j) { const f32x4 v = xr[64 * j]; u32x2 w; w.x = cvtpk(v.x, v.y); w.y = cvtpk(v.z, v.w); ((u32x2*)orow)[lane + 64 * j] = w;
        const float r0 = __uint_as_float(w.x << 16), r1 = __uint_as_float(w.x & 0xffff0000u), r2 = __uint_as_float(w.y << 16), r3 = __uint_as_float(w.y & 0xffff0000u);
        s += (r0 * r0 + r1 * r1) + (r2 * r2 + r3 * r3); }
    s = wave_sum(s);
    if (lane < 32) ss[lane] = s * (1.0f / 32.0f);
}
__device__ __forceinline__ void final_row(float* orow, const bf16* hrow, const float* g, const float* ss, int lane) {
    const float rstd = 1.0f / sqrtf(wave_sum(lane < 32 ? ss[lane] : 0.f) * (1.0f / D) + RMS_EPS);
    f32x4* xr = (f32x4*)orow + lane; const f32x4* gr = (const f32x4*)g + lane; const u32x2* hr = (const u32x2*)hrow + lane;
#pragma unroll
    for (int j = 0; j < 8; ++j) { const u32x2 a = hr[64 * j]; f32x4 v;
        v.x = __uint_as_float(a.x << 16); v.y = __uint_as_float(a.x & 0xffff0000u); v.z = __uint_as_float(a.y << 16); v.w = __uint_as_float(a.y & 0xffff0000u);
        xr[64 * j] = v * rstd * gr[64 * j]; }
}

#define MFMA32(a, b, c) __builtin_amdgcn_mfma_f32_32x32x16_bf16(a, b, c, 0, 0, 0)
struct WCtx { int lane, q, h; LAS unsigned char* vbuf; unsigned wb[4]; unsigned trb0, trb1; };
__device__ __forceinline__ void wctx_init(WCtx& w, LAS unsigned char* vbuf, int lane) {
    w.lane = lane; w.q = lane & 31; w.h = lane >> 5; w.vbuf = vbuf;
    const int ch = lane & 15, kr = lane >> 4;
#pragma unroll
    for (int x = 0; x < 4; ++x) w.wb[x] = (unsigned)(512 * (ch >> 2) + 64 * kr + 16 * ((ch & 3) ^ x));
    const int qq = (lane & 15) >> 2, p = lane & 3, blk = (lane >> 4) & 1, h = lane >> 5;
    const int x0 = (2 * blk + (p >> 1)) ^ (2 * h);
    w.trb0 = (unsigned)(2048 * h + 64 * qq + 16 * x0 + 8 * (p & 1));
    w.trb1 = (unsigned)(2048 * h + 256 + 64 * qq + 16 * (x0 ^ 1) + 8 * (p & 1));
}
__device__ __forceinline__ void load_q(const bf16* qrow  , bf16x8 (&qf)[8]) {
#pragma unroll
    for (int s = 0; s < 8; ++s) qf[s] = *(const bf16x8*)(qrow + 16 * s);
}
__device__ __forceinline__ f32x16 qk_tile(const bf16* krow  , const bf16x8 (&qf)[8]) {
    bf16x8 kf[8];
#pragma unroll
    for (int s = 0; s < 8; ++s) kf[s] = *(const bf16x8*)(krow + 16 * s);
    f32x16 acc;
#pragma unroll
    for (int i = 0; i < 16; ++i) acc[i] = 0.f;
#pragma unroll
    for (int s = 0; s < 8; ++s) acc = MFMA32(kf[s], qf[s], acc);
    return acc;
}
__device__ __forceinline__ void load_v(const bf16* vt, size_t stride, const WCtx& w, u32x4 (&vr)[8]) {
    const bf16* p = vt + (size_t)(w.lane >> 4) * stride + (w.lane & 15) * 8;
#pragma unroll
    for (int i = 0; i < 8; ++i) vr[i] = *(const u32x4*)(p + (size_t)(4 * i) * stride);
}
__device__ __forceinline__ void stage_v(const WCtx& w, const u32x4 (&vr)[8]) {
#pragma unroll
    for (int i = 0; i < 8; ++i)
        *(LAS u32x4*)(w.vbuf + (2048 * ((i & 1) + 2 * (i >> 2)) + 256 * ((i >> 1) & 1)) + w.wb[((i >> 1) & 1) + 2 * (i & 1)]) = vr[i];
}
__device__ __forceinline__ void pv_tile(const WCtx& w, const bf16x8 (&pf)[2], f32x16 (&o)[4]) {
#pragma unroll
    for (int ks = 0; ks < 2; ++ks)
#pragma unroll
        for (int c = 0; c < 4; ++c) {
            const s16x4 lo = __builtin_amdgcn_ds_read_tr16_b64_v4i16((LAS s16x4*)(w.vbuf + w.trb0 + 4096 * ks + 512 * c));
            const s16x4 hi = __builtin_amdgcn_ds_read_tr16_b64_v4i16((LAS s16x4*)(w.vbuf + w.trb1 + 4096 * ks + 512 * c));
            bf16x8 a; a[0] = lo[0]; a[1] = lo[1]; a[2] = lo[2]; a[3] = lo[3]; a[4] = hi[0]; a[5] = hi[1]; a[6] = hi[2]; a[7] = hi[3];
            o[c] = MFMA32(a, pf[ks], o[c]);
        }
}
__device__ __forceinline__ void pv_tile_b(const LAS unsigned char* vimg, const WCtx& w, const bf16x8 (&pf)[2], f32x16 (&o)[4]) {
#pragma unroll
    for (int ks = 0; ks < 2; ++ks)
#pragma unroll
        for (int c = 0; c < 4; ++c) {
            const s16x4 lo = __builtin_amdgcn_ds_read_tr16_b64_v4i16((LAS s16x4*)(vimg + w.trb0 + 4096 * ks + 512 * c));
            const s16x4 hi = __builtin_amdgcn_ds_read_tr16_b64_v4i16((LAS s16x4*)(vimg + w.trb1 + 4096 * ks + 512 * c));
            bf16x8 a; a[0] = lo[0]; a[1] = lo[1]; a[2] = lo[2]; a[3] = lo[3]; a[4] = hi[0]; a[5] = hi[1]; a[6] = hi[2]; a[7] = hi[3];
            o[c] = MFMA32(a, pf[ks], o[c]);
        }
}
__device__ __forceinline__ void pack_p(const float (&p)[16], bf16x8 (&pf)[2]) {
#pragma unroll
    for (int ks = 0; ks < 2; ++ks) {
        u32x4 w; w.x = cvtpk(p[8 * ks + 0], p[8 * ks + 1]); w.y = cvtpk(p[8 * ks + 2], p[8 * ks + 3]); w.z = cvtpk(p[8 * ks + 4], p[8 * ks + 5]); w.w = cvtpk(p[8 * ks + 6], p[8 * ks + 7]);
        pf[ks] = __builtin_bit_cast(bf16x8, w); }
}
__device__ __forceinline__ float xh_max(float v) { const auto r = __builtin_amdgcn_permlane32_swap(__float_as_uint(v), __float_as_uint(v), false, false); return fmaxf(__uint_as_float(r[0]), __uint_as_float(r[1])); }
__device__ __forceinline__ float xh_sum(float v) { const auto r = __builtin_amdgcn_permlane32_swap(__float_as_uint(v), __float_as_uint(v), false, false); return __uint_as_float(r[0]) + __uint_as_float(r[1]); }
__device__ __forceinline__ float xh_other(float v, int h) { const auto r = __builtin_amdgcn_permlane32_swap(__float_as_uint(v), __float_as_uint(v), false, false); return __uint_as_float(h == 0 ? r[1] : r[0]); }
__device__ __forceinline__ void softmax_step(const float (&s)[16], float& m, float& l, f32x16 (&o)[4], bf16x8 (&pf)[2]) {
    float mx = s[0];
#pragma unroll
    for (int i = 1; i < 16; ++i) mx = fmaxf(mx, s[i]);
    mx = xh_max(mx);
    const float mn = fmaxf(m, mx), mu = (mn == -INFINITY) ? 0.f : mn;
    const float alpha = __builtin_amdgcn_exp2f(m - mu);
    float p[16], ps = 0.f;
#pragma unroll
    for (int i = 0; i < 16; ++i) { p[i] = __builtin_amdgcn_exp2f(s[i] - mu); ps += p[i]; }
    l = l * alpha + ps; m = mn;
    if (__builtin_amdgcn_ballot_w64(alpha != 1.0f) != 0ull) {
#pragma unroll
        for (int c = 0; c < 4; ++c)
#pragma unroll
            for (int i = 0; i < 16; ++i) o[c][i] *= alpha; }
    pack_p(p, pf);
}
__device__ __forceinline__ void write_o(const f32x16 (&o)[4], float mul, bf16* orow, int h) {
#pragma unroll
    for (int c = 0; c < 4; ++c)
#pragma unroll
        for (int g = 0; g < 4; ++g) { u32x2 w; w.x = cvtpk(o[c][4 * g] * mul, o[c][4 * g + 1] * mul); w.y = cvtpk(o[c][4 * g + 2] * mul, o[c][4 * g + 3] * mul);
            *(u32x2*)(orow + 32 * c + 8 * g + 4 * h) = w; }
}
#define ZERO_O(o) do { _Pragma("unroll") for (int c_ = 0; c_ < 4; ++c_) _Pragma("unroll") for (int i_ = 0; i_ < 16; ++i_) o[c_][i_] = 0.f; } while (0)

__device__ __forceinline__ void load_k(const bf16* krow  , bf16x8 (&kf)[8]) {
#pragma unroll
    for (int s = 0; s < 8; ++s) kf[s] = *(const bf16x8*)(krow + 16 * s);
}
__device__ __forceinline__ void load_kt(const bf16* kt  , bf16x8 (&kf)[8]) {
#pragma unroll
    for (int s = 0; s < 8; ++s) kf[s] = *(const bf16x8*)(kt + 512 * s);
}
__device__ __forceinline__ f32x16 qk_mma(const bf16x8 (&kf)[8], const bf16x8 (&qf)[8]) {
    f32x16 acc;
#pragma unroll
    for (int i = 0; i < 16; ++i) acc[i] = 0.f;
#pragma unroll
    for (int s = 0; s < 8; ++s) acc = MFMA32(kf[s], qf[s], acc);
    return acc;
}
__device__ __forceinline__ void load_vp(const bf16* p  , size_t stride, u32x4 (&vr)[8]) {
#pragma unroll
    for (int i = 0; i < 8; ++i) vr[i] = *(const u32x4*)(p + (size_t)(4 * i) * stride);
}

__device__ __forceinline__ void stage_k(LAS unsigned char* kimg, int lane, const u32x4 (&kr)[8]) {
    LAS unsigned char* p = kimg + ((unsigned)lane & 15u) * 528u + ((unsigned)lane >> 4) * 16u;
#pragma unroll
    for (int i = 0; i < 8; ++i) *(LAS u32x4*)(p + 64 * i) = kr[i];
}
__device__ __forceinline__ f32x16 qk_mma_img(const LAS unsigned char* kimg, int lane, const bf16x8 (&qf)[8]) {
    const LAS unsigned char* p = kimg + ((unsigned)lane >> 5) * 528u + ((unsigned)lane & 31u) * 16u;
    bf16x8 kf[8];
#pragma unroll
    for (int s = 0; s < 8; ++s) kf[s] = *(const LAS bf16x8*)(p + 1056 * s);
    return qk_mma(kf, qf);
}

#define PIN16(a) asm volatile("" : "+v"(a[0]), "+v"(a[1]), "+v"(a[2]), "+v"(a[3]), "+v"(a[4]), "+v"(a[5]), "+v"(a[6]), "+v"(a[7]), "+v"(a[8]), "+v"(a[9]), "+v"(a[10]), "+v"(a[11]), "+v"(a[12]), "+v"(a[13]), "+v"(a[14]), "+v"(a[15]))
__device__ __forceinline__ void dilated_wave(const bf16* qkv, int b, int head, int r, int c, int l0, bf16* obase, int o_ld, float* lse_out, const LAS float* btab, LAS unsigned char* kimg  , const WCtx& w) {
    const size_t tokq = (size_t)b * SEQ + (size_t)(l0 + w.q) * r + c;
    bf16x8 qf[8]; load_q(qkv + tokq * NQKV + head * HD + 8 * w.h, qf);
    f32x16 o[4]; ZERO_O(o); float m = -INFINITY, l = 0.f;
    const size_t vstride = (size_t)r * NQKV, tstep = 32 * vstride;
    int j = l0 >= 128 ? 0 : (128 - l0) >> 5;
    const size_t tok0 = (size_t)b * SEQ + (size_t)(l0 - 128 + 32 * j) * r + c;
    const bf16* vp = qkv + (tok0 + (size_t)(w.lane >> 4) * r) * NQKV + 2 * D + head * HD + (w.lane & 15) * 8;
    const bf16* kp = vp - D;
    u32x4 kr[8]; u32x4 vr[8]; load_vp(kp, vstride, kr); load_vp(vp, vstride, vr);
#pragma unroll 1
    for (;;) {
        stage_k(kimg, w.lane, kr);
        const f32x16 acc = qk_mma_img(kimg, w.lane, qf);
        const bool more = j < 4;
        if (more) { kp += tstep; load_vp(kp, vstride, kr); }
        float s[16], bv[16];
#pragma unroll
        for (int i = 0; i < 16; ++i) { const int kk = 8 * (i >> 2) + 4 * w.h + (i & 3); const int rel = 128 - 32 * j + w.q - kk;
            bv[i] = btab[min(max(rel, 0), 128) * r]; }
        PIN16(bv);
#pragma unroll
        for (int i = 0; i < 16; ++i) { const int kk = 8 * (i >> 2) + 4 * w.h + (i & 3);
            const bool valid = ((j != 0) | (kk >= w.q)) & ((j != 4) | (kk <= w.q));
            s[i] = fminf(acc[i] * SC2 + bv[i], valid ? INFINITY : -INFINITY); }
        bf16x8 pf[2]; softmax_step(s, m, l, o, pf);
        stage_v(w, vr);
        pv_tile(w, pf, o);
        if (!more) break;
        vp += tstep; load_vp(vp, vstride, vr);
        ++j;
    }
    const float lt = xh_sum(l), inv = 1.0f / lt;
    write_o(o, inv, obase + tokq * o_ld + head * HD, w.h);
    if (w.h == 0) lse_out[tokq * 8 + head] = m + __builtin_amdgcn_logf(lt);
}

__device__ __forceinline__ void moba_wave(const bf16* qkv, const bf16* KT, const float* kmq, int b, int hh, int t0, bf16* O, const LAS float* btab, const LAS unsigned char* bkt, const WCtx& w) {
    const int head = 8 + hh, own = t0 >> 8;
    const size_t tokq = (size_t)b * SEQ + t0 + w.q;
    bf16x8 qf[8]; load_q(qkv + tokq * NQKV + head * HD + 8 * w.h, qf);
    unsigned sel = (1u << own) - 1u;
    if (own > 3) {
        const int n = w.q & 15; const size_t ko = ((size_t)(b * 8 + hh) * 16 + n) * HD + 8 * w.h; constexpr size_t QS = (size_t)BATCH * 8 * 16 * HD;
        f32x16 g;
#pragma unroll
        for (int i = 0; i < 16; ++i) g[i] = 0.f;
#pragma unroll
        for (int s = 0; s < 8; ++s) {
            f32x4 a0 = *(const f32x4*)(kmq + ko + 16 * s), a1 = *(const f32x4*)(kmq + ko + 16 * s + 4);
#pragma unroll
            for (int qd = 1; qd < 4; ++qd) { a0 += *(const f32x4*)(kmq + qd * QS + ko + 16 * s); a1 += *(const f32x4*)(kmq + qd * QS + ko + 16 * s + 4); }
            a0 *= (1.0f / 256.0f); a1 *= (1.0f / 256.0f);
            u32x4 hi; hi.x = cvtpk(a0[0], a0[1]); hi.y = cvtpk(a0[2], a0[3]); hi.z = cvtpk(a1[0], a1[1]); hi.w = cvtpk(a1[2], a1[3]);
            u32x4 lo; lo.x = cvtpk(a0[0] - __uint_as_float(hi.x << 16), a0[1] - __uint_as_float(hi.x & 0xffff0000u)); lo.y = cvtpk(a0[2] - __uint_as_float(hi.y << 16), a0[3] - __uint_as_float(hi.y & 0xffff0000u));
            lo.z = cvtpk(a1[0] - __uint_as_float(hi.z << 16), a1[1] - __uint_as_float(hi.z & 0xffff0000u)); lo.w = cvtpk(a1[2] - __uint_as_float(hi.w << 16), a1[3] - __uint_as_float(hi.w & 0xffff0000u));
            g = MFMA32(__builtin_bit_cast(bf16x8, hi), qf[s], g); g = MFMA32(__builtin_bit_cast(bf16x8, lo), qf[s], g); }
        float pg[8], gv[16];
#pragma unroll
        for (int i = 0; i < 8; ++i) pg[i] = xh_other(g[i], w.h);
#pragma unroll
        for (int nn = 0; nn < 16; ++nn) { const int a = nn >> 3, bb = (nn >> 2) & 1, e = nn & 3; const float v = (bb == w.h) ? g[4 * a + e] : pg[4 * a + e]; gv[nn] = (nn < own) ? v : -INFINITY; }
        sel = 0u;
#pragma unroll
        for (int rd = 0; rd < 3; ++rd) { float best = -INFINITY; int bi = 0;
#pragma unroll
            for (int nn = 0; nn < 16; ++nn) { const bool take = !((sel >> nn) & 1u) && (gv[nn] > best); best = take ? gv[nn] : best; bi = take ? nn : bi; }
            sel |= 1u << bi; }
    }
    unsigned bm = 1u << own;
#pragma unroll
    for (int n = 0; n < 15; ++n) if (__builtin_amdgcn_ballot_w64((sel >> n) & 1u) != 0ull) bm |= 1u << n;
    const int jd = (t0 & 255) >> 5;
    f32x16 o[4]; ZERO_O(o); float m = -INFINITY, l = 0.f;
    const bf16* kb = KT + ((size_t)((b * 16 + head) * 128) << 12) + w.lane * 8;
    const bf16* vb = qkv + ((size_t)b * SEQ + (w.lane >> 4)) * NQKV + 2 * D + head * HD + (w.lane & 15) * 8;
    int nb = __builtin_ctz(bm), jj = 0;
    bf16x8 kf[8]; u32x4 vr[8];
    { load_kt(kb + ((size_t)(nb * 8) << 12), kf); load_vp(vb + (size_t)(nb * 256) * NQKV, NQKV, vr); }
#pragma unroll 1
    for (;;) {
        const f32x16 acc = qk_mma(kf, qf);
        int nb2 = nb, jj2 = jj + 1; unsigned bm2 = bm;
        if (jj2 > (nb == own ? jd : 7)) { bm2 &= bm2 - 1u; jj2 = 0; nb2 = bm2 ? __builtin_ctz(bm2) : 0; }
        const bool more = bm2 != 0u;
        const size_t ko2 = (size_t)(nb2 * 256 + 32 * jj2) * NQKV;
        if (more) load_kt(kb + ((size_t)(nb2 * 8 + jj2) << 12), kf);
        const int key0 = nb * 256 + 32 * jj, dq = t0 - key0 + w.q - 4 * w.h;
        const bool rowsel = (nb == own) || ((sel >> nb) & 1u);
        float s[16];
        const int dlt = t0 - key0;
        bool uni = false;
        if (dlt >= 31) uni = __builtin_amdgcn_readfirstlane((int)bkt[dlt - 31]) == __builtin_amdgcn_readfirstlane((int)bkt[dlt + 31]);
        if (uni) {
            const float bu = btab[dlt], lim = rowsel ? INFINITY : -INFINITY;
#pragma unroll
            for (int i = 0; i < 16; ++i) s[i] = fminf(acc[i] * SC2 + bu, lim);
        } else {
#pragma unroll
            for (int i = 0; i < 16; ++i) { const int dist = dq - (8 * (i >> 2) + (i & 3)); const bool valid = rowsel && dist >= 0; const float v = acc[i] * SC2 + btab[max(dist, 0)]; s[i] = fminf(v, valid ? INFINITY : -INFINITY); }
        }
        bf16x8 pf[2]; softmax_step(s, m, l, o, pf);
        stage_v(w, vr);
        pv_tile(w, pf, o);
        if (!more) break;
        load_vp(vb + ko2, NQKV, vr);
        nb = nb2; jj = jj2; bm = bm2;
    }
    const float lt = xh_sum(l), inv = 1.0f / lt;
    write_o(o, inv, O + tokq * D + head * HD, w.h);
}

__device__ __forceinline__ void moba_logits(const f32x16& acc, int t0, int key0, bool rowsel, const LAS float* btab, const LAS unsigned char* bkt, const WCtx& w, float (&s)[16]) {
    const int dlt = t0 - key0, dq = dlt + w.q - 4 * w.h;
    bool uni = false;
    if (dlt >= 31) uni = __builtin_amdgcn_readfirstlane((int)bkt[dlt - 31]) == __builtin_amdgcn_readfirstlane((int)bkt[dlt + 31]);
    if (uni) {
        const float bu = btab[dlt], lim = rowsel ? INFINITY : -INFINITY;
#pragma unroll
        for (int i = 0; i < 16; ++i) s[i] = fminf(acc[i] * SC2 + bu, lim);
    } else {
        float bv[16];
#pragma unroll
        for (int i = 0; i < 16; ++i) bv[i] = btab[max(dq - (8 * (i >> 2) + (i & 3)), 0)];
        PIN16(bv);
#pragma unroll
        for (int i = 0; i < 16; ++i) { const int dist = dq - (8 * (i >> 2) + (i & 3)); const bool valid = rowsel && dist >= 0; s[i] = fminf(acc[i] * SC2 + bv[i], valid ? INFINITY : -INFINITY); }
    }
}
__device__ __forceinline__ void softmax_step2(const float (&sa)[16], const float (&sb)[16], float& m, float& l, f32x16 (&o)[4], bf16x8 (&pfa)[2], bf16x8 (&pfb)[2]) {
    float mx = fmaxf(sa[0], sb[0]);
#pragma unroll
    for (int i = 1; i < 16; ++i) mx = fmaxf(mx, fmaxf(sa[i], sb[i]));
    mx = xh_max(mx);
    const float mn = fmaxf(m, mx), mu = (mn == -INFINITY) ? 0.f : mn;
    const float alpha = __builtin_amdgcn_exp2f(m - mu);
    float pa[16], pb[16], ps = 0.f;
#pragma unroll
    for (int i = 0; i < 16; ++i) { pa[i] = __builtin_amdgcn_exp2f(sa[i] - mu); pb[i] = __builtin_amdgcn_exp2f(sb[i] - mu); ps += pa[i] + pb[i]; }
    l = l * alpha + ps; m = mn;
    if (__builtin_amdgcn_ballot_w64(alpha != 1.0f) != 0ull) {
#pragma unroll
        for (int c = 0; c < 4; ++c)
#pragma unroll
            for (int i = 0; i < 16; ++i) o[c][i] *= alpha; }
    pack_p(pa, pfa); pack_p(pb, pfb);
}

__device__ __forceinline__ void moba_wg(const bf16* qkv, const bf16* KT, const float* kmq, int b, int hh, int own, int wave, int tid, bf16* O, const LAS float* btab, const LAS unsigned char* bkt, LAS unsigned char* lds, const WCtx& w) {
    const int head = 8 + hh, t0 = own * 256 + wave * 32;
    const size_t tokq = (size_t)b * SEQ + t0 + w.q;
    bf16x8 qf[8]; load_q(qkv + tokq * NQKV + head * HD + 8 * w.h, qf);
    unsigned sel = (1u << own) - 1u;
    if (own > 3) {
        const int n = w.q & 15; const size_t ko = ((size_t)(b * 8 + hh) * 16 + n) * HD + 8 * w.h; constexpr size_t QS = (size_t)BATCH * 8 * 16 * HD;
        f32x16 g;
#pragma unroll
        for (int i = 0; i < 16; ++i) g[i] = 0.f;
#pragma unroll
        for (int s = 0; s < 8; ++s) {
            f32x4 a0 = *(const f32x4*)(kmq + ko + 16 * s), a1 = *(const f32x4*)(kmq + ko + 16 * s + 4);
#pragma unroll
            for (int qd = 1; qd < 4; ++qd) { a0 += *(const f32x4*)(kmq + qd * QS + ko + 16 * s); a1 += *(const f32x4*)(kmq + qd * QS + ko + 16 * s + 4); }
            a0 *= (1.0f / 256.0f); a1 *= (1.0f / 256.0f);
            u32x4 hi; hi.x = cvtpk(a0[0], a0[1]); hi.y = cvtpk(a0[2], a0[3]); hi.z = cvtpk(a1[0], a1[1]); hi.w = cvtpk(a1[2], a1[3]);
            u32x4 lo; lo.x = cvtpk(a0[0] - __uint_as_float(hi.x << 16), a0[1] - __uint_as_float(hi.x & 0xffff0000u)); lo.y = cvtpk(a0[2] - __uint_as_float(hi.y << 16), a0[3] - __uint_as_float(hi.y & 0xffff0000u));
            lo.z = cvtpk(a1[0] - __uint_as_float(hi.z << 16), a1[1] - __uint_as_float(hi.z & 0xffff0000u)); lo.w = cvtpk(a1[2] - __uint_as_float(hi.w << 16), a1[3] - __uint_as_float(hi.w & 0xffff0000u));
            g = MFMA32(__builtin_bit_cast(bf16x8, hi), qf[s], g); g = MFMA32(__builtin_bit_cast(bf16x8, lo), qf[s], g); }
        float pg[8], gv[16];
#pragma unroll
        for (int i = 0; i < 8; ++i) pg[i] = xh_other(g[i], w.h);
#pragma unroll
        for (int nn = 0; nn < 16; ++nn) { const int a = nn >> 3, bb = (nn >> 2) & 1, e = nn & 3; const float v = (bb == w.h) ? g[4 * a + e] : pg[4 * a + e]; gv[nn] = (nn < own) ? v : -INFINITY; }
        sel = 0u;
#pragma unroll
        for (int rd = 0; rd < 3; ++rd) { float best = -INFINITY; int bi = 0;
#pragma unroll
            for (int nn = 0; nn < 16; ++nn) { const bool take = !((sel >> nn) & 1u) && (gv[nn] > best); best = take ? gv[nn] : best; bi = take ? nn : bi; }
            sel |= 1u << bi; }
    }
    unsigned bmw = 1u << own;
#pragma unroll
    for (int n = 0; n < 15; ++n) if (__builtin_amdgcn_ballot_w64((sel >> n) & 1u) != 0ull) bmw |= 1u << n;
    LAS unsigned* wgw = (LAS unsigned*)(lds + 86016);
    if (tid == 0) wgw[0] = 0u;
    __syncthreads();
    if (w.lane == 0) __hip_atomic_fetch_or(wgw, bmw, __ATOMIC_RELAXED, __HIP_MEMORY_SCOPE_WORKGROUP);
    __syncthreads();
    unsigned bm = (unsigned)__builtin_amdgcn_readfirstlane((int)wgw[0]);
    f32x16 o[4]; ZERO_O(o); float m = -INFINITY, l = 0.f;
    const bf16* kg = KT + ((size_t)((b * 16 + head) * 128) << 12) + tid * 8;
    const bf16* vg = qkv + ((size_t)b * SEQ + (tid >> 4)) * NQKV + 2 * D + head * HD + (tid & 15) * 8;
    const unsigned kst = (unsigned)tid * 16u;
    unsigned vst; { const int kr = w.lane >> 4, ch = w.lane & 15, x = ((wave >> 1) & 1) + 2 * (wave & 1);
        vst = (unsigned)(8192 + 2048 * ((wave & 1) + 2 * (wave >> 2)) + 256 * ((wave >> 1) & 1) + 512 * (ch >> 2) + 64 * kr + 16 * ((ch & 3) ^ x)); }
    int nb = __builtin_ctz(bm), u = 0, buf = 0;
    u32x4 kra, vra, krb, vrb;
    { const size_t t = (size_t)(nb * 8); const size_t k0 = (size_t)(nb * 256) * NQKV;
      kra = *(const u32x4*)(kg + (t << 12)); krb = *(const u32x4*)(kg + ((t + 1) << 12)); vra = *(const u32x4*)(vg + k0); vrb = *(const u32x4*)(vg + k0 + (size_t)32 * NQKV); }
    *(LAS u32x4*)(lds + kst) = kra; *(LAS u32x4*)(lds + vst) = vra; *(LAS u32x4*)(lds + 16384 + kst) = krb; *(LAS u32x4*)(lds + 16384 + vst) = vrb;
    __syncthreads();
#pragma unroll 1
    for (;;) {
        int nb2 = nb, u2 = u + 1; unsigned bm2 = bm;
        if (u2 > 3) { bm2 &= bm2 - 1u; u2 = 0; nb2 = bm2 ? __builtin_ctz(bm2) : 0; }
        const bool more = bm2 != 0u;
        if (more) { const size_t t = (size_t)(nb2 * 8 + 2 * u2); const size_t k0 = (size_t)(nb2 * 256 + 64 * u2) * NQKV;
            kra = *(const u32x4*)(kg + (t << 12)); krb = *(const u32x4*)(kg + ((t + 1) << 12)); vra = *(const u32x4*)(vg + k0); vrb = *(const u32x4*)(vg + k0 + (size_t)32 * NQKV); }
        const bool mine = ((bmw >> nb) & 1u) && (nb != own || 2 * u <= wave);
        if (mine) {
            const LAS unsigned char* base = lds + buf * 32768;
            const LAS unsigned char* kimg = base + w.lane * 16;
            bf16x8 kfa[8], kfb[8];
#pragma unroll
            for (int s = 0; s < 8; ++s) { kfa[s] = *(const LAS bf16x8*)(kimg + 1024 * s); kfb[s] = *(const LAS bf16x8*)(kimg + 16384 + 1024 * s); }
            f32x16 acca, accb;
#pragma unroll
            for (int i = 0; i < 16; ++i) { acca[i] = 0.f; accb[i] = 0.f; }
#pragma unroll
            for (int s = 0; s < 8; ++s) { acca = MFMA32(kfa[s], qf[s], acca); accb = MFMA32(kfb[s], qf[s], accb); }
            const int key0 = nb * 256 + 64 * u;
            const bool rowsel = (nb == own) || ((sel >> nb) & 1u);
            float sa[16], sb[16];
            moba_logits(acca, t0, key0, rowsel, btab, bkt, w, sa);
            moba_logits(accb, t0, key0 + 32, rowsel, btab, bkt, w, sb);
            bf16x8 pfa[2], pfb[2]; softmax_step2(sa, sb, m, l, o, pfa, pfb);
            pv_tile_b(base + 8192, w, pfa, o);
            pv_tile_b(base + 16384 + 8192, w, pfb, o);
        }
        if (more) { LAS unsigned char* nb_ = lds + (buf ^ 1) * 32768;
            *(LAS u32x4*)(nb_ + kst) = kra; *(LAS u32x4*)(nb_ + vst) = vra; *(LAS u32x4*)(nb_ + 16384 + kst) = krb; *(LAS u32x4*)(nb_ + 16384 + vst) = vrb; }
        __syncthreads();
        if (!more) break;
        nb = nb2; u = u2; bm = bm2; buf ^= 1;
    }
    const float lt = xh_sum(l), inv = 1.0f / lt;
    write_o(o, inv, O + tokq * D + head * HD, w.h);
}

__device__ __forceinline__ void sb_wave(const bf16* qkv, const bf16* KT, int b, int head, int t0, bf16* O, const WCtx& w) {
    const size_t tokq = (size_t)b * SEQ + t0 + w.q;
    bf16x8 qf[8]; load_q(qkv + tokq * NQKV + head * HD + 8 * w.h, qf);
    f32x16 o[4]; ZERO_O(o); float carry = 0.f;
    const bf16* kp = KT + ((size_t)((b * 16 + head) * 128 + (t0 >> 5)) << 12) + w.lane * 8;
    const bf16* vp = qkv + ((size_t)b * SEQ + t0 + (w.lane >> 4)) * NQKV + 2 * D + head * HD + (w.lane & 15) * 8;
    bf16x8 kf[8]; u32x4 vr[8]; load_kt(kp, kf); load_vp(vp, NQKV, vr);
    int kt = t0 >> 5; const int ktd = kt;
#pragma unroll 1
    for (;;) {
        const f32x16 acc = qk_mma(kf, qf);
        const bool diag = (kt == ktd), notlast = kt > 0;
        if (notlast) { kp -= 4096; load_kt(kp, kf); }
        float lk[16], ls[16];
#pragma unroll
        for (int i = 0; i < 16; ++i) { const int kk = 8 * (i >> 2) + 4 * w.h + (i & 3); const bool past = !diag || (kk < w.q);
            const float z = acc[i] * SC2, az = fabsf(z), e = __builtin_amdgcn_exp2f(-az), L = __builtin_amdgcn_logf(1.0f + e);
            lk[i] = past ? -(fmaxf(z, 0.f) + L) : 0.f; ls[i] = past ? (fminf(z, 0.f) - L) : -INFINITY; }
        float sg[4], pg[4];
#pragma unroll
        for (int g = 0; g < 4; ++g) { sg[g] = (lk[4 * g] + lk[4 * g + 1]) + (lk[4 * g + 2] + lk[4 * g + 3]); pg[g] = xh_other(sg[g], w.h); }
        float run = 0.f, p[16];
#pragma unroll
        for (int g = 3; g >= 0; --g) {
            float bt = carry + run + (w.h == 0 ? pg[g] : 0.f);
#pragma unroll
            for (int e = 3; e >= 0; --e) { p[4 * g + e] = __builtin_amdgcn_exp2f(ls[4 * g + e] + bt); bt += lk[4 * g + e]; }
            run += sg[g] + pg[g]; }
        carry += run;
        bf16x8 pf[2]; pack_p(p, pf);
        const bool more = notlast && (__builtin_amdgcn_ballot_w64(carry >= -170.0f) != 0ull);
        stage_v(w, vr);
        pv_tile(w, pf, o);
        if (!more) break;
        vp -= (size_t)32 * NQKV; load_vp(vp, NQKV, vr);
        --kt;
    }
    write_o(o, 1.0f, O + tokq * D + head * HD, w.h);
}

__device__ __forceinline__ void kmean_wave(const bf16* KT, float* kmq, int wt, int lane) {
    const int qd = wt & 3, n = (wt >> 2) & 15, hh = (wt >> 6) & 7, b = wt >> 9;
    const bf16* kp = KT + ((size_t)((b * 16 + 8 + hh) * 128 + n * 8 + qd * 2) << 12) + (lane >> 3) * 512 + ((lane >> 2) & 1) * 256 + 2 * (lane & 3);
    float s0 = 0.f, s1 = 0.f;
#pragma unroll 16
    for (int j = 0; j < 64; ++j) { const unsigned v = *(const unsigned*)(kp + (size_t)(j >> 5) * 4096 + (j & 31) * 8); s0 += __uint_as_float(v << 16); s1 += __uint_as_float(v & 0xffff0000u); }
    float* o = kmq + (size_t)qd * BATCH * 8 * 16 * HD + ((size_t)(b * 8 + hh) * 16 + n) * HD + 2 * lane;
    o[0] = s0; o[1] = s1;
}
__device__ __forceinline__ void combine_wave(bf16* O, const bf16* br1, const bf16* br2, const float* lse, int tok, int lane) {
    const int head = lane >> 3, d0 = (lane & 7) * 16;
    const float l0 = lse[(size_t)tok * 8 + head], l1 = lse[(size_t)M * 8 + (size_t)tok * 8 + head], l2 = lse[(size_t)2 * M * 8 + (size_t)tok * 8 + head];
    const float mx = fmaxf(l0, fmaxf(l1, l2)); float a0 = __builtin_amdgcn_exp2f(l0 - mx), a1 = __builtin_amdgcn_exp2f(l1 - mx), a2 = __builtin_amdgcn_exp2f(l2 - mx);
    const float inv = 1.0f / (a0 + a1 + a2); a0 *= inv; a1 *= inv; a2 *= inv;
    bf16* po = O + (size_t)tok * D + head * HD + d0; const bf16* p1 = br1 + (size_t)tok * 1024 + head * HD + d0; const bf16* p2 = br2 + (size_t)tok * 1024 + head * HD + d0;
#pragma unroll
    for (int k = 0; k < 2; ++k) {
        const u32x4 x0 = *(const u32x4*)(po + 8 * k), x1 = *(const u32x4*)(p1 + 8 * k), x2 = *(const u32x4*)(p2 + 8 * k); u32x4 y;
#pragma unroll
        for (int e = 0; e < 4; ++e) {
            const float lo = a0 * __uint_as_float(x0[e] << 16) + a1 * __uint_as_float(x1[e] << 16) + a2 * __uint_as_float(x2[e] << 16);
            const float hi = a0 * __uint_as_float(x0[e] & 0xffff0000u) + a1 * __uint_as_float(x1[e] & 0xffff0000u) + a2 * __uint_as_float(x2[e] & 0xffff0000u);
            y[e] = cvtpk(lo, hi); }
        *(u32x4*)(po + 8 * k) = y; }
}

template <class T> __device__ __forceinline__ T* opaque(T* p) {
    unsigned lo = __builtin_amdgcn_readfirstlane((unsigned)(unsigned long long)p), hi = __builtin_amdgcn_readfirstlane((unsigned)((unsigned long long)p >> 32));
    asm volatile("" : "+s"(lo), "+s"(hi)); return (T*)(__attribute__((address_space(1))) T*)(((unsigned long long)hi << 32) | lo); }
__device__ __forceinline__ int opaque_v(int v) { asm volatile("" : "+v"(v)); return v; }

#define RLX_AGENT __ATOMIC_RELAXED, __HIP_MEMORY_SCOPE_AGENT
#define XB_TMO      128
#define XB_XCNT(j)  (256  + 64 * (j))
#define XB_XSUB(j)  (1280 + 64 * (j))
#define XB_XGEN(j)  (2304 + 64 * (j))
#define XB_TOP      3328
#define XB_TOPGEN   3392
#define XCD_BAR_WORDS 3456
#define XB_SPIN_CAP (1u << 18)

__device__ __forceinline__ unsigned xb_ld(unsigned* p)              { return __hip_atomic_load(p, __ATOMIC_RELAXED, __HIP_MEMORY_SCOPE_AGENT); }
__device__ __forceinline__ unsigned xb_add(unsigned* p, unsigned v) { return __hip_atomic_fetch_add(p, v, __ATOMIC_RELAXED, __HIP_MEMORY_SCOPE_AGENT); }
__device__ __forceinline__ unsigned xb_xcc_id() { return (unsigned)__builtin_amdgcn_s_getreg((3 << 11) | 20) & 0xFu; }
#define XB_SPIN(cond, bar) do { unsigned _sp = 0; while (cond) { __builtin_amdgcn_s_sleep(1); \
    if ((++_sp & 255u) == 0u) { if (xb_ld(&(bar)[XB_TMO])) break; if (_sp > XB_SPIN_CAP) { atomicAdd(&(bar)[XB_TMO], 1u); break; } } } } while (0)

struct XcdBarrier {
    int wv;
    unsigned* bar; unsigned x;
    volatile LAS unsigned* st;
};

__device__ __forceinline__ XcdBarrier xcd_barrier_post(unsigned* bar, volatile LAS unsigned* st) {
    XcdBarrier b; b.wv = __builtin_amdgcn_readfirstlane((int)(threadIdx.x >> 6)); b.bar = bar; b.x = xb_xcc_id(); b.st = st;
    if (threadIdx.x == 0) (void)xb_add(&bar[XB_XCNT(b.x)], 1u);
    return b;
}
__device__ __forceinline__ void xcd_barrier_complete(unsigned* bar, unsigned x, unsigned& nloc, unsigned& nx) {
    const unsigned G = gridDim.x * gridDim.y * gridDim.z;
    unsigned sum, cnt, mine, sp = 0u;
    for (;;) {
        sum = 0u; cnt = 0u; mine = 0u;
#pragma unroll
        for (unsigned j = 0; j < 16; ++j) { const unsigned c = xb_ld(&bar[XB_XCNT(j)]); sum += c; cnt += (c > 0u) ? 1u : 0u; mine = (j == x) ? c : mine; }
        if (sum == G) break;
        __builtin_amdgcn_s_sleep(1);
        if ((++sp & 255u) == 0u) { if (xb_ld(&bar[XB_TMO])) break; if (sp > XB_SPIN_CAP) { atomicAdd(&bar[XB_TMO], 1u); break; } }
    }
    nloc = mine > 0u ? mine : 1u; nx = cnt > 0u ? cnt : 1u;
}

__device__ __forceinline__ void xcd_barrier(const XcdBarrier& b) {
    asm volatile("s_waitcnt vmcnt(0)" ::: "memory");
    __syncthreads();
    if (b.wv == 0 && pg8::lane_id() == 0) {
        unsigned* bar = b.bar;
        __builtin_amdgcn_s_waitcnt(0);
        unsigned nloc = b.st[0], nx = b.st[1];
        if (nloc == 0u) { xcd_barrier_complete(bar, b.x, nloc, nx); b.st[0] = nloc; b.st[1] = nx; }
        const unsigned old = xb_add(&bar[XB_XSUB(b.x)], 1u);
        const unsigned gen = old / nloc;
        if (old + 1u == (gen + 1u) * nloc) {
            __builtin_amdgcn_fence(__ATOMIC_RELEASE, "agent");
            asm volatile("s_waitcnt vmcnt(0)" ::: "memory");
            const unsigned og = xb_add(&bar[XB_TOP], 1u);
            const unsigned tg = og / nx;
            if (og + 1u == (tg + 1u) * nx) xb_add(&bar[XB_TOPGEN], 1u);
            else XB_SPIN(xb_ld(&bar[XB_TOPGEN]) == tg, bar);
            __builtin_amdgcn_fence(__ATOMIC_ACQUIRE, "agent");
            xb_add(&bar[XB_XGEN(b.x)], 1u);
            asm volatile("s_waitcnt vmcnt(0)" ::: "memory");
        } else {
            XB_SPIN(xb_ld(&bar[XB_XGEN(b.x)]) == gen, bar);
            __builtin_amdgcn_fence(__ATOMIC_ACQUIRE, "agent");
            asm volatile("s_waitcnt vmcnt(0)" ::: "memory");
        }
    }
    __syncthreads();
}


#define TIDX (wave_s * 64 + pg8::lane_id())
#ifndef REP_BAR
#define REP_BAR 1
#endif
#define STAMP() do { } while (0)
#define GRID_BAR() do { for (int rb_ = 0; rb_ < REP_BAR; ++rb_) xcd_barrier(bar); STAMP(); } while (0)
template <int s>
__device__ __forceinline__ void fwd_step(const Args& args, LAS unsigned char* lds, const XcdBarrier& bar, const int wave_s, const int cidx  ) {
        const int layer = s / 3, k3 = s - 3 * layer;
        if (k3 != 1) {
            const int widx = layer * 2 + (k3 >> 1);
            {
                unsigned char* ws = opaque(args.ws); const int G = gridDim.x, bx = blockIdx.x;
                pg8::Gemm g{(const bf16*)(ws + WS_U), (const bf16*)(ws + WS_W1 + widx * SZ_W1), M, 2 * FF, D}; pg8::StaticOrder S; S.init(M, 2 * FF, G, cidx);
                const float* ssp = (const float*)(ws + WS_SS) + (size_t)s * M * 32; LAS float* rt = (LAS float*)(lds + 155712);
                pg8::Unit u0; S.next(0, u0);
                { const int t_ = TIDX; if (t_ < 256) { const f32x4* pp = (const f32x4*)(ssp + (size_t)(u0.pm * 256 + t_) * 32); f32x4 a = pp[0];
#pragma unroll
                    for (int k = 1; k < 8; ++k) a += pp[k];
                    rt[t_] = __builtin_amdgcn_rsqf(((a.x + a.y) + (a.z + a.w)) * (1.0f / 2048.0f) + 1e-6f); } }
                __syncthreads();
                pg8::EpiSwiglu E{(bf16*)(ws + WS_BIG), FF, ssp, u0.pm};
                for (int rep = 0; rep < REP_GEMM; ++rep) { if (rep > 0) GRID_BAR(); pg8::gemm_phase<pg8::EpiSwiglu, pg8::StaticOrder, true, true>(lds, g, S, E, wave_s); }
            }
            GRID_BAR();
            {
                unsigned char* ws = opaque(args.ws); const int G = gridDim.x, bx = blockIdx.x; float* out = opaque(args.out);
                pg8::Gemm g{(const bf16*)(ws + WS_BIG), (const bf16*)(ws + WS_W2 + widx * SZ_W2), M, D, FF}; pg8::StaticOrder S; S.init(M, D, G, cidx);
                pg8::EpiResid E{(bf16*)(ws + WS_U), (float*)(ws + WS_SS) + (size_t)(s + 1) * M * 32, D, 0.5f};
                pg8::gemm_phase<pg8::EpiResid, pg8::StaticOrder, true, true>(lds, g, S, E, wave_s);
            }
            GRID_BAR();
        } else {
            {
                unsigned char* ws = opaque(args.ws); const int G = gridDim.x, bx = blockIdx.x;
                pg8::Gemm g{(const bf16*)(ws + WS_U), (const bf16*)(ws + WS_WQKV + layer * SZ_WQKV), M, NQKV, D}; pg8::StaticOrder S; S.init(M, NQKV, G, cidx);
                const float* ssp = (const float*)(ws + WS_SS) + (size_t)s * M * 32; LAS float* rt = (LAS float*)(lds + 155712);
                pg8::Unit u0; S.next(0, u0);
                { const int t_ = TIDX; if (t_ < 256) { const f32x4* pp = (const f32x4*)(ssp + (size_t)(u0.pm * 256 + t_) * 32); f32x4 a = pp[0];
#pragma unroll
                    for (int k = 1; k < 8; ++k) a += pp[k];
                    rt[t_] = __builtin_amdgcn_rsqf(((a.x + a.y) + (a.z + a.w)) * (1.0f / 2048.0f) + 1e-6f); } }
                __syncthreads();
                pg8::EpiQkv E{(bf16*)(ws + WS_BIG), NQKV, ssp, u0.pm, (bf16*)(ws + WS_KT), layer == 0 ? 12 : 8};
                for (int rep = 0; rep < REP_GEMM; ++rep) { if (rep > 0) GRID_BAR(); pg8::gemm_phase<pg8::EpiQkv, pg8::StaticOrder, true, true>(lds, g, S, E, wave_s); }
            }
            GRID_BAR();
            if (layer == 0) {
                {
                    unsigned char* ws = opaque(args.ws); const int G = gridDim.x, bx = blockIdx.x;
                    const int tid = opaque_v(TIDX), lane = tid & 63, wave = __builtin_amdgcn_readfirstlane(tid >> 6);
                    const bf16* BIG = (const bf16*)(ws + WS_BIG); bf16* OB = (bf16*)(ws + WS_O); bf16* BR1 = (bf16*)opaque(args.out); bf16* BR2 = BR1 + (size_t)M * 1024;
                    float* LSE = (float*)(ws + WS_LSE); const float* BIAS = (const float*)(ws + WS_BIAS);
                    LAS float* btab = (LAS float*)(lds + 133120);
                    WCtx w; wctx_init(w, lds + wave * 8192, lane);
                    int cur_head = -1;
                    for (int rep = 0; rep < REP_DIL; ++rep)
                    for (int task = bx; task < 1536; task += G) {
                        {
                            const int ri = task >> 9, rem = task & 511, b = rem >> 7, head = (rem >> 4) & 7, grp = rem & 15;
                            const int r = ri == 0 ? 1 : (ri == 1 ? 4 : 16), sh = ri == 0 ? 7 : (ri == 1 ? 5 : 3), wt = grp * 8 + wave, c = wt >> sh, l0 = (wt - (c << sh)) * 32;
                            if (head != cur_head) {
                                __syncthreads();
                                for (int i = tid; i < 2112; i += NTHR) btab[i] = BIAS[head * 4096 + i];
                                __syncthreads();
                                cur_head = head; }
                            bf16* ob = ri == 0 ? OB : (ri == 1 ? BR1 : BR2);
                            dilated_wave(BIG, b, head, r, c, l0, ob, ri == 0 ? D : 1024, LSE + (size_t)ri * M * 8, btab, lds + 65536 + wave * 8448, w);
                        }
                    }
                    for (int wt = bx * NWAVES + wave; wt < 2048; wt += G * NWAVES) kmean_wave((const bf16*)(ws + WS_KT), (float*)(ws + WS_KMH), wt, lane);
                }
                GRID_BAR();
                {
                    unsigned char* ws = opaque(args.ws); const int G = gridDim.x, bx = blockIdx.x;
                    const int tid = opaque_v(TIDX), lane = tid & 63, wave = __builtin_amdgcn_readfirstlane(tid >> 6);
                    const bf16* BIG = (const bf16*)(ws + WS_BIG); bf16* OB = (bf16*)(ws + WS_O); bf16* BR1 = (bf16*)opaque(args.out); bf16* BR2 = BR1 + (size_t)M * 1024;
                    const float* BIAS = (const float*)(ws + WS_BIAS);
                    LAS float* btab = (LAS float*)(lds + 65536);
                    WCtx w; wctx_init(w, lds + wave * 8192, lane);
                    int cur_hh = -1;
                    for (int rep = 0; rep < REP_MOBA; ++rep)
                    for (int task = bx; task < 512; task += G) {
                        const int tt = task & 255, b = tt >> 6, hh = (tt >> 3) & 7, xx = tt & 7, own = task < 256 ? xx : 15 - xx;
                        if (hh != cur_hh) {
                            __syncthreads();
                            for (int i = tid; i < 4096; i += NTHR) btab[i] = BIAS[(8 + hh) * 4096 + i];
                            for (int i = tid; i < 1024; i += NTHR) ((LAS unsigned*)(lds + 81920))[i] = ((const unsigned*)(ws + WS_BKT))[i];
                            __syncthreads();
                            cur_hh = hh; }
                        moba_wg(BIG, (const bf16*)(ws + WS_KT), (const float*)(ws + WS_KMH), b, hh, own, wave, tid, OB, btab, (const LAS unsigned char*)(lds + 81920), lds, w);
                    }
                    const int gw = bx * NWAVES + wave, NGW = G * NWAVES;
                    for (int tok = gw; tok < M; tok += NGW) combine_wave(OB, BR1, BR2, (const float*)(ws + WS_LSE), tok, lane);
                }
                GRID_BAR();
            } else {
                {
                    unsigned char* ws = opaque(args.ws); const int G = gridDim.x, bx = blockIdx.x;
                    const int tid = opaque_v(TIDX), lane = tid & 63, wave = __builtin_amdgcn_readfirstlane(tid >> 6);
                    WCtx w; wctx_init(w, lds + wave * 8192, lane);
                    for (int rep = 0; rep < REP_SB; ++rep)
                    for (int task = bx; task < 1024; task += G) {
                        const int b = task >> 8, head = (task >> 4) & 15, qb = task & 15;
                        sb_wave((const bf16*)(ws + WS_BIG), (const bf16*)(ws + WS_KT), b, head, qb * 256 + wave * 32, (bf16*)(ws + WS_O), w);
                    }
                }
                GRID_BAR();
            }
            {
                unsigned char* ws = opaque(args.ws); const int G = gridDim.x, bx = blockIdx.x; float* out = opaque(args.out);
                pg8::Gemm g{(const bf16*)(ws + WS_O), (const bf16*)(ws + WS_WO + layer * SZ_WO), M, D, D}; pg8::StaticOrder S; S.init(M, D, G, cidx);
                pg8::EpiResid E{(bf16*)(ws + WS_U), (float*)(ws + WS_SS) + (size_t)(s + 1) * M * 32, D, 1.0f};
                pg8::gemm_phase<pg8::EpiResid, pg8::StaticOrder, true, true>(lds, g, S, E, wave_s);
            }
            GRID_BAR();
        }
}

__global__ void __launch_bounds__(NTHR, 2) fwd_megakernel(Args args) {
    cg::grid_group grid = cg::this_grid();
    LAS unsigned char* lds = (LAS unsigned char*)pg8::lds_raw;
    volatile LAS unsigned* bst = (volatile LAS unsigned*)(lds + 155648);
    if (threadIdx.x < 2) bst[threadIdx.x] = 0u;
    __syncthreads();
    const XcdBarrier bar = xcd_barrier_post((unsigned*)(args.ws + WS_CTL), bst);
    const int wave_s = bar.wv;
    unsigned* xcnt = (unsigned*)(args.ws + WS_CTL + 15360);
    if (TIDX == 0) bst[4] = __hip_atomic_fetch_add(xcnt + 16 * bar.x, 1u, __ATOMIC_RELAXED, __HIP_MEMORY_SCOPE_AGENT);

#ifndef REP_ALL
#define REP_ALL 1
#endif
    STAMP();
#pragma unroll 1
    for (int rep_all = 0; rep_all < REP_ALL; ++rep_all) {
    if (rep_all > 0) GRID_BAR();
    {
        const int tid = opaque_v(TIDX), lane = tid & 63, wave = __builtin_amdgcn_readfirstlane(tid >> 6);
        const int G = gridDim.x, bx = blockIdx.x, gw = bx * NWAVES + wave, NGW = G * NWAVES;
        for (int rep = 0; rep < REP_P0; ++rep)
        p0_weights(args, gw, NGW, lane);
        p0_bias(args, bx * NTHR + tid, G * NTHR);
        const float* x = as_global(args.in[0]); unsigned char* wsg = as_global(args.ws); bf16* HB = (bf16*)(wsg + WS_U); float* SS = (float*)(wsg + WS_SS);
        for (int mrow = gw; mrow < M; mrow += NGW) x_row(x + (size_t)mrow * D, HB + (size_t)mrow * D, SS + (size_t)mrow * 32, lane);
    }
    if (rep_all == 0) { grid.sync(); STAMP(); } else GRID_BAR();
    if (TIDX == 0) { bool even = (gridDim.x % 8u) == 0u;
        for (int j = 0; j < 8; ++j) even = even && (__hip_atomic_load(xcnt + 16 * j, __ATOMIC_RELAXED, __HIP_MEMORY_SCOPE_AGENT) == gridDim.x / 8u);
        bst[5] = (even && bar.x < 8u) ? (bst[4] * 8u + bar.x) : blockIdx.x; }
    __syncthreads();
    const int cidx = __builtin_amdgcn_readfirstlane((int)bst[5]);

    fwd_step<0>(args, lds, bar, wave_s, cidx); fwd_step<1>(args, lds, bar, wave_s, cidx); fwd_step<2>(args, lds, bar, wave_s, cidx);
    fwd_step<3>(args, lds, bar, wave_s, cidx); fwd_step<4>(args, lds, bar, wave_s, cidx); fwd_step<5>(args, lds, bar, wave_s, cidx);
    {
        unsigned char* ws = opaque(args.ws); float* out = opaque(args.out);
        const int tid = opaque_v(TIDX), lane = tid & 63, wave = __builtin_amdgcn_readfirstlane(tid >> 6);
        const int gw = blockIdx.x * NWAVES + wave, NGW = gridDim.x * NWAVES;
        const float* g = as_global(args.in[10]); const float* SS = (const float*)(ws + WS_SS) + (size_t)6 * M * 32;
        for (int mrow = gw; mrow < M; mrow += NGW) final_row(out + (size_t)mrow * D, (const bf16*)(ws + WS_U) + (size_t)mrow * D, g, SS + (size_t)mrow * 32, lane);
    }
    }
}

extern "C" void kernel_launch(void* const* d_in, const int* in_sizes, int n_in, void* d_out, int out_size, void* d_ws, size_t ws_size, hipStream_t stream) {
    static int grid = 0;
    if (grid == 0) {
        if (n_in != 11 || in_sizes[0] != M * D || out_size != M * D || ws_size < WS_END) {
            fprintf(stderr, "kernel_launch: shape/workspace mismatch (n_in %d, in0 %d, out %d, ws %zu, need %zu); nothing launched\n", n_in, n_in > 0 ? in_sizes[0] : -1, out_size, ws_size, (size_t)WS_END);
            grid = -1; return; }
        int dev = 0, cus = 0, per_cu = 0;
        (void)hipGetDevice(&dev); (void)hipDeviceGetAttribute(&cus, hipDeviceAttributeMultiprocessorCount, dev);
        if (hipFuncSetAttribute((const void*)fwd_megakernel, hipFuncAttributeMaxDynamicSharedMemorySize, LDS_BYTES) != hipSuccess) { fprintf(stderr, "kernel_launch: hipFuncSetAttribute failed\n"); grid = -1; return; }
        if (hipOccupancyMaxActiveBlocksPerMultiprocessor(&per_cu, (const void*)fwd_megakernel, NTHR, LDS_BYTES) != hipSuccess || per_cu < 1) { fprintf(stderr, "kernel_launch: occupancy query gave %d\n", per_cu); per_cu = 1; }
        (void)hipGetLastError();
        grid = cus * 1;
        if (grid > 256) grid = 256;
        if (grid != 256) { fprintf(stderr, "kernel_launch: built for a 256-CU MI355X (the GEMM epilogues rely on the 256-workgroup unit order); device has %d CUs; nothing launched\n", cus); grid = -1; return; }
    }
    if (grid < 0) return;
    if (hipMemsetAsync((char*)d_ws + WS_CTL, 0, CTL_BYTES, stream) != hipSuccess) { fprintf(stderr, "kernel_launch: memset of the barrier words failed\n"); return; }
    Args a{};
    for (int i = 0; i < 11; ++i) a.in[i] = (const float*)d_in[i];
    a.out = (float*)d_out; a.ws = (unsigned char*)d_ws;
    void* kargs[] = {&a};
    hipError_t e = hipLaunchCooperativeKernel((const void*)fwd_megakernel, dim3(grid), dim3(NTHR), kargs, LDS_BYTES, stream);
    if (e != hipSuccess) fprintf(stderr, "kernel_launch: cooperative launch failed: %s (grid %d)\n", hipGetErrorString(e), grid);
}
```

```cpp
#include <hip/hip_runtime.h>
#include <hip/hip_cooperative_groups.h>
#include <cstdio>
#include <cstdint>
namespace cg = cooperative_groups;
namespace pg8 {
#define PG8_LAS __attribute__((address_space(3)))
extern __shared__ __attribute__((aligned(16))) unsigned char lds_raw[];
__device__ __forceinline__ int lane_id() { return (int)__builtin_amdgcn_mbcnt_hi(~0u, __builtin_amdgcn_mbcnt_lo(~0u, 0u)); }
typedef unsigned short bf16_t;
typedef short bf16x8 __attribute__((ext_vector_type(8)));
typedef float f32x4 __attribute__((ext_vector_type(4)));
typedef unsigned u32x4 __attribute__((ext_vector_type(4)));
constexpr int BM = 256, BK = 64, HALF = 128, HTB = HALF * BK * 2  , STAGE_BYTES = 8 * HTB, NXCD = 8, WGM = 8;

__host__ __device__ __forceinline__ int lds_byte(int r, int c) { const int st = (r >> 4) * 2 + (c >> 5), rr = r & 15, cc = c & 31, ob = rr * 64 + cc * 2; return st * 1024 + (ob ^ (((ob >> 9) & 1) << 5)); }
__host__ __device__ __forceinline__ void stage_rc(int b, int& R, int& C) { const int st = b / 1024, sb = b % 1024, swz = sb ^ (((sb >> 9) & 1) << 5); R = (st >> 1) * 16 + swz / 64; C = (st & 1) * 32 + (swz % 64) / 2; }
__host__ __device__ __forceinline__ int perm32(int rho) { const int n = rho >> 4, i = rho & 15; return 8 * (i >> 2) + 4 * n + (i & 3); }

struct Unit { int pm, pn; };
struct Gemm { const bf16_t* A; const bf16_t* Bt; int M, N, K; };

struct StaticOrder {
    int nM, nN, nwg, G, c;
    __host__ __device__ void init(int M, int N, int G_, int c_) { nM = M / BM; nN = N / BM; nwg = nM * nN; G = G_; c = c_; }
    __host__ __device__ bool next(int i, Unit& u) const {
        const long L = (long)i * G + c; if (L >= nwg) return false;
        int wgid = (int)L; { const int q = nwg / NXCD, r = nwg % NXCD, xcd = wgid % NXCD, off = wgid / NXCD; wgid = (xcd < r ? xcd * (q + 1) : r * (q + 1) + (xcd - r) * q) + off; }
        const int nig = WGM * nN, gid = wgid / nig, fm = gid * WGM, gsz = (nM - fm) < WGM ? (nM - fm) : WGM;
        u.pm = fm + ((wgid % nig) % gsz); u.pn = (wgid % nig) / gsz; return true;
    }
    __device__ __forceinline__ void a_ready(const Unit&) const {}
    __device__ __forceinline__ void done(const Unit&) const {}
};

__device__ __forceinline__ unsigned cvt_pk_bf16(float lo, float hi) { unsigned r; asm volatile("v_cvt_pk_bf16_f32 %0, %1, %2" : "=v"(r) : "v"(lo), "v"(hi)); return r; }
typedef float f32x2 __attribute__((ext_vector_type(2)));
__device__ __forceinline__ f32x2 gelu_pk(f32x2 v) {
    const f32x2 av = __builtin_elementwise_abs(v), d = av * 0.2316418882f + 1.0f;
    f32x2 t; t.x = __builtin_amdgcn_rcpf(d.x); t.y = __builtin_amdgcn_rcpf(d.y);
    f32x2 q = t * 0.5307027145f + (-0.7265760135f); q = q * t + 0.7107068705f; q = q * t + (-0.142248368f); q = q * t + 0.127414796f; q = q * t;
    const f32x2 s = (v * v) * (-0.72134752044f);
    f32x2 e; e.x = __builtin_amdgcn_exp2f(s.x); e.y = __builtin_amdgcn_exp2f(s.y);
    const f32x2 m = v * (q * e), r = v - m;
    f32x2 o; o.x = v.x < 0.f ? m.x : r.x; o.y = v.y < 0.f ? m.y : r.y; return o;
}

template <int ACT  > struct EpiBf16 {
    static constexpr bool PERM = true, AFTER_DRAIN = false; static_assert(ACT == 0 || ACT == 1, "EpiBf16: ACT is 0 (none) or 1 (gelu_pk)");
    bf16_t* O; int ldc; const float* bias; int split_cols; size_t split_stride; float scale0;
    __device__ __forceinline__ void operator()(const f32x4 (&acc)[2][2][4][2], const Unit& u, int wr, int wc, int fr, int fq) const {
        const int row0 = u.pm * BM + wr * 64 + fr; int colt = u.pn * BM; bf16_t* base = O;
        float sc = 1.f; if (split_cols) { const int t = colt / split_cols; base += (size_t)t * split_stride; colt -= t * split_cols; if (t == 0) sc = scale0; }
        const int col0 = colt + wc * 32 + 8 * fq, bcol0 = u.pn * BM + wc * 32 + 8 * fq;
        f32x4 bv[2][2];
#pragma unroll
        for (int bj = 0; bj < 2; ++bj)
#pragma unroll
            for (int n = 0; n < 2; ++n) bv[bj][n] = bias ? *(const f32x4*)(bias + bcol0 + bj * HALF + 4 * n) : (f32x4){0.f, 0.f, 0.f, 0.f};
#pragma unroll
        for (int ai = 0; ai < 2; ++ai)
#pragma unroll
            for (int m = 0; m < 4; ++m) { bf16_t* rowp = base + (size_t)(row0 + ai * HALF + m * 16) * ldc + col0;
#pragma unroll
                for (int bj = 0; bj < 2; ++bj) { f32x4 v0 = acc[ai][bj][m][0] + bv[bj][0], v1 = acc[ai][bj][m][1] + bv[bj][1];
                    if (ACT == 1) { f32x2 a = gelu_pk((f32x2){v0[0], v0[1]}), b = gelu_pk((f32x2){v0[2], v0[3]}), c = gelu_pk((f32x2){v1[0], v1[1]}), d = gelu_pk((f32x2){v1[2], v1[3]});
                        v0 = (f32x4){a.x, a.y, b.x, b.y}; v1 = (f32x4){c.x, c.y, d.x, d.y}; }
                    v0 = v0 * sc; v1 = v1 * sc; u32x4 w; w.x = cvt_pk_bf16(v0[0], v0[1]); w.y = cvt_pk_bf16(v0[2], v0[3]); w.z = cvt_pk_bf16(v1[0], v1[1]); w.w = cvt_pk_bf16(v1[2], v1[3]);
                    *(u32x4*)(rowp + bj * HALF) = w; } }
    }
};
__device__ __forceinline__ void load_rstd8_lds(const PG8_LAS float* rt, int rloc, float (&rs)[2][4]) {
#pragma unroll
    for (int ai = 0; ai < 2; ++ai)
#pragma unroll
        for (int m = 0; m < 4; ++m) rs[ai][m] = rt[rloc + ai * HALF + m * 16];
}
__device__ __forceinline__ void load_rstd8(const float* ss, int row0, float (&rs)[2][4]) {
    float v[2][4];
#pragma unroll
    for (int ai = 0; ai < 2; ++ai)
#pragma unroll
        for (int m = 0; m < 4; ++m) v[ai][m] = ss[row0 + ai * HALF + m * 16];
#pragma unroll
    for (int ai = 0; ai < 2; ++ai)
#pragma unroll
        for (int m = 0; m < 4; ++m) rs[ai][m] = __builtin_amdgcn_rsqf(v[ai][m] * (1.0f / 2048.0f) + 1e-6f);
}
struct EpiSwiglu {
    static constexpr bool PERM = true, AFTER_DRAIN = false;
    bf16_t* O; int ldc; const float* ss; int pm0;
    __device__ __forceinline__ void operator()(const f32x4 (&acc)[2][2][4][2], const Unit& u, int wr, int wc, int fr, int fq) const {
        const int row0 = u.pm * BM + wr * 64 + fr, col0 = (43 - u.pn) * HALF + wc * 32 + 8 * fq;
        float rsv[2][4]; load_rstd8_lds((const PG8_LAS float*)((PG8_LAS unsigned char*)lds_raw + 155712), wr * 64 + fr, rsv);
#pragma unroll
        for (int ai = 0; ai < 2; ++ai)
#pragma unroll
            for (int m = 0; m < 4; ++m) {
                const int row = row0 + ai * HALF + m * 16; bf16_t* rowp = O + (size_t)row * ldc + col0;
                const float rs = rsv[ai][m];
                float r[8];
#pragma unroll
                for (int n = 0; n < 2; ++n)
#pragma unroll
                    for (int e = 0; e < 4; ++e) { const float g = acc[ai][0][m][n][e] * rs, up = acc[ai][1][m][n][e] * rs;
                        const float sg = g * __builtin_amdgcn_rcpf(1.0f + __builtin_amdgcn_exp2f(-1.44269504089f * g)); r[4 * n + e] = sg * up; }
                u32x4 w; w.x = cvt_pk_bf16(r[0], r[1]); w.y = cvt_pk_bf16(r[2], r[3]); w.z = cvt_pk_bf16(r[4], r[5]); w.w = cvt_pk_bf16(r[6], r[7]);
                *(u32x4*)rowp = w; }
    }
};
struct EpiResid {
    static constexpr bool PERM = true, AFTER_DRAIN = false;
    bf16_t* hi; float* ss; int ldc; float scale;
    __device__ __forceinline__ void operator()(const f32x4 (&acc)[2][2][4][2], const Unit& u, int wr, int wc, int fr, int fq) const {
        const int row0 = u.pm * BM + wr * 64 + fr, col0 = u.pn * BM + wc * 32 + 8 * fq;
#pragma unroll
        for (int ai = 0; ai < 2; ++ai)
#pragma unroll
            for (int m = 0; m < 4; ++m) { const int row = row0 + ai * HALF + m * 16; const size_t off = (size_t)row * ldc + col0; float q = 0.f;
#pragma unroll
                for (int bj = 0; bj < 2; ++bj) { const size_t ix = off + bj * HALF;
                    const u32x4 xh = *(const u32x4*)(hi + ix);
                    u32x4 wh;
#pragma unroll
                    for (int e = 0; e < 4; ++e) {
                        const float a = acc[ai][bj][m][e >> 1][2 * (e & 1)], b = acc[ai][bj][m][e >> 1][2 * (e & 1) + 1];
                        const float o0 = __uint_as_float(xh[e] << 16) + a * scale, o1 = __uint_as_float(xh[e] & 0xffff0000u) + b * scale;
                        const unsigned h2 = cvt_pk_bf16(o0, o1); wh[e] = h2;
                        const float r0 = __uint_as_float(h2 << 16), r1 = __uint_as_float(h2 & 0xffff0000u);
                        q += r0 * r0 + r1 * r1; }
                    *(u32x4*)(hi + ix) = wh; }
                q += __shfl_xor(q, 16); q += __shfl_xor(q, 32);
                if (fq == 0) ss[(size_t)row * 32 + u.pn * 4 + wc] = q;
                }
    }
};
struct EpiQkv {
    static constexpr bool PERM = true, AFTER_DRAIN = false;
    bf16_t* O; int ldc; const float* ss; int pm0; bf16_t* KT; int kt_lo;
    __device__ __forceinline__ void operator()(const f32x4 (&acc)[2][2][4][2], const Unit& u, int wr, int wc, int fr, int fq) const {
        const int row0 = u.pm * BM + wr * 64 + fr, col0 = u.pn * BM + wc * 32 + 8 * fq;
        float rsv[2][4]; load_rstd8_lds((const PG8_LAS float*)((PG8_LAS unsigned char*)lds_raw + 155712), wr * 64 + fr, rsv);
        if (u.pn >= kt_lo && u.pn < 16) {
#pragma unroll
            for (int ai = 0; ai < 2; ++ai)
#pragma unroll
                for (int m = 0; m < 4; ++m) { const int row = row0 + ai * HALF + m * 16;
                    const float rs = rsv[ai][m];
                    const int b = row >> 12, key = row & 4095;
#pragma unroll
                    for (int bj = 0; bj < 2; ++bj) { const int head = (u.pn - 8) * 2 + bj;
                        bf16_t* p = KT + ((size_t)((b * 16 + head) * 128 + (key >> 5)) << 12) + (wc * 2 + (fq >> 1)) * 512 + ((fq & 1) * 32 + (key & 31)) * 8;
                        const f32x4 v0 = acc[ai][bj][m][0] * rs, v1 = acc[ai][bj][m][1] * rs;
                        u32x4 w; w.x = cvt_pk_bf16(v0[0], v0[1]); w.y = cvt_pk_bf16(v0[2], v0[3]); w.z = cvt_pk_bf16(v1[0], v1[1]); w.w = cvt_pk_bf16(v1[2], v1[3]);
                        *(u32x4*)p = w; } }
            return; }
#pragma unroll
        for (int ai = 0; ai < 2; ++ai)
#pragma unroll
            for (int m = 0; m < 4; ++m) { const int row = row0 + ai * HALF + m * 16;
                const float rs = rsv[ai][m];
                bf16_t* rowp = O + (size_t)row * ldc + col0;
#pragma unroll
                for (int bj = 0; bj < 2; ++bj) { const f32x4 v0 = acc[ai][bj][m][0] * rs, v1 = acc[ai][bj][m][1] * rs;
                    u32x4 w; w.x = cvt_pk_bf16(v0[0], v0[1]); w.y = cvt_pk_bf16(v0[2], v0[3]); w.z = cvt_pk_bf16(v1[0], v1[1]); w.w = cvt_pk_bf16(v1[2], v1[3]);
                    *(u32x4*)(rowp + bj * HALF) = w; } }
    }
};
template <class Epi, class Sched, bool ALIGN_EPI = false, bool SP2 = false>
__device__ __forceinline__ void gemm_phase(PG8_LAS unsigned char* lds, const Gemm g, const Sched& S, const Epi& E, int wave_s  ) {
    int tid_ = wave_s * 64 + lane_id(); asm volatile("" : "+v"(tid_));
    const int tid = tid_, wid = __builtin_amdgcn_readfirstlane(tid >> 6), lane = tid & 63, wr = wid >> 2, wc = wid & 3, fr = lane & 15, fq = lane >> 4;
    const int K = g.K, nt = K / BK;
    unsigned voffA[2], voffB[2];
#pragma unroll
    for (int i = 0; i < 2; ++i) { int R, C; stage_rc(tid * 16 + i * 8192, R, C); const int Rb = Epi::PERM ? ((R & ~31) + perm32(R & 31)) : R;
        voffA[i] = (unsigned)(R * K + C) * 2u; voffB[i] = (unsigned)(Rb * K + C) * 2u; }
    const size_t kstep = (size_t)(BK * 2);
    const size_t hstep = (size_t)HALF * K * 2;
    const size_t tstep = 2 * hstep;
    const unsigned ldsw = (unsigned)wid * 1024u;
    const int aoff = lds_byte(wr * 64 + fr, fq * 8), boff = lds_byte(wc * 32 + fr, fq * 8);
#define PG8_SA(b, h) (((b) * 2 + (h)) * HTB)
#define PG8_SB(b, h) ((4 + (b) * 2 + (h)) * HTB)
#define PG8_STAGE(bufoff, gbase, voff) do { _Pragma("unroll") for (int _i = 0; _i < 2; ++_i) \
        __builtin_amdgcn_global_load_lds((const unsigned*)((const char*)(gbase) + (voff)[_i]), (PG8_LAS unsigned*)(lds + (bufoff) + ldsw + _i * 8192), 16, 0, 0); } while (0)
#define PG8_LDA(dst, b, h) do { _Pragma("unroll") for (int m = 0; m < 4; ++m) _Pragma("unroll") for (int k = 0; k < 2; ++k) dst[m][k] = *(const PG8_LAS bf16x8*)(lds + PG8_SA(b, h) + aoff + m * 2048 + k * 1024); } while (0)
#define PG8_LDB(dst, b, h) do { _Pragma("unroll") for (int n = 0; n < 2; ++n) _Pragma("unroll") for (int k = 0; k < 2; ++k) dst[n][k] = *(const PG8_LAS bf16x8*)(lds + PG8_SB(b, h) + boff + n * 2048 + k * 1024); } while (0)
#define PG8_MMA(ai, bj, At, Bt) do { __builtin_amdgcn_s_setprio(1); _Pragma("unroll") for (int m = 0; m < 4; ++m) _Pragma("unroll") for (int n = 0; n < 2; ++n) _Pragma("unroll") for (int k = 0; k < 2; ++k) \
        acc[ai][bj][m][n] = __builtin_amdgcn_mfma_f32_16x16x32_bf16(Bt[n][k], At[m][k], acc[ai][bj][m][n], 0, 0, 0); __builtin_amdgcn_s_setprio(0); } while (0)
#define PG8_WAIT_V(n) asm volatile("s_waitcnt vmcnt(" #n ")" ::: "memory")
#define PG8_WAIT_L(n) asm volatile("s_waitcnt lgkmcnt(" #n ")" ::: "memory")
#define PG8_BAR __builtin_amdgcn_s_barrier()
#define PG8_SCHED __builtin_amdgcn_sched_barrier(0)
    Unit cur, nxt; int ui = 0;
    if (!S.next(0, cur)) return;
    f32x4 acc[2][2][4][2];
#pragma unroll
    for (int a = 0; a < 2; ++a)
#pragma unroll
        for (int b = 0; b < 2; ++b)
#pragma unroll
            for (int m = 0; m < 4; ++m)
#pragma unroll
                for (int n = 0; n < 2; ++n) acc[a][b][m][n] = (f32x4){0.f, 0.f, 0.f, 0.f};
    bf16x8 At[4][2], B0[2][2], B1[2][2];
    const char* cA = (const char*)g.A + (size_t)cur.pm * tstep; const char* cB = (const char*)g.Bt + (size_t)cur.pn * tstep;
    S.a_ready(cur);
    if constexpr (SP2) {
        PG8_STAGE(PG8_SB(0, 0), cB, voffB); PG8_STAGE(PG8_SB(0, 1), cB + hstep, voffB); PG8_STAGE(PG8_SA(0, 0), cA, voffA); PG8_STAGE(PG8_SA(0, 1), cA + hstep, voffA);
        if (wr == 1) PG8_BAR;
        PG8_WAIT_V(2); PG8_BAR;
        PG8_STAGE(PG8_SB(1, 0), cB + kstep, voffB); PG8_STAGE(PG8_SA(1, 0), cA + kstep, voffA); PG8_STAGE(PG8_SB(1, 1), cB + hstep + kstep, voffB);
        PG8_WAIT_V(6); PG8_BAR;
    } else {
        PG8_STAGE(PG8_SB(0, 0), cB, voffB); PG8_STAGE(PG8_SA(0, 0), cA, voffA); PG8_STAGE(PG8_SB(0, 1), cB + hstep, voffB); PG8_STAGE(PG8_SA(0, 1), cA + hstep, voffA);
        if (wr == 1) PG8_BAR;
        PG8_WAIT_V(4); PG8_BAR;
        PG8_STAGE(PG8_SB(1, 0), cB + kstep, voffB); PG8_STAGE(PG8_SA(1, 0), cA + kstep, voffA); PG8_STAGE(PG8_SB(1, 1), cB + hstep + kstep, voffB);
        PG8_WAIT_V(6); PG8_BAR;
    }
    for (;;) {
        const bool has_next = S.next(ui + 1, nxt);
        const char* nA = has_next ? (const char*)g.A + (size_t)nxt.pm * tstep : cA; const char* nB = has_next ? (const char*)g.Bt + (size_t)nxt.pn * tstep : cB;
        for (int t = 0; t < nt; t += 2) {
            const bool last = (t == nt - 2);
            const char* a1 = cA + (size_t)(t + 1) * kstep;
            const char* a2 = last ? nA : cA + (size_t)(t + 2) * kstep; const char* b2 = last ? nB : cB + (size_t)(t + 2) * kstep;
            const char* a3 = a2 + kstep; const char* b3 = b2 + kstep;
            if (last && has_next) S.a_ready(nxt);
            if constexpr (SP2) {
            PG8_LDB(B0, 0, 0); PG8_LDB(B1, 0, 1); PG8_SCHED; PG8_LDA(At, 0, 0); PG8_STAGE(PG8_SA(1, 1), a1 + hstep, voffA);
            PG8_WAIT_V(8); PG8_WAIT_L(0); PG8_BAR; PG8_MMA(0, 0, At, B0); PG8_MMA(0, 1, At, B1); PG8_BAR; PG8_SCHED;
            PG8_LDA(At, 0, 1); PG8_STAGE(PG8_SB(0, 0), b2, voffB); PG8_STAGE(PG8_SB(0, 1), b2 + hstep, voffB); PG8_STAGE(PG8_SA(0, 0), a2, voffA);
            PG8_WAIT_V(8); PG8_WAIT_L(0); PG8_BAR; PG8_MMA(1, 0, At, B0); PG8_MMA(1, 1, At, B1); PG8_BAR; PG8_SCHED;
            PG8_LDB(B0, 1, 0); PG8_LDB(B1, 1, 1); PG8_SCHED; PG8_LDA(At, 1, 0); PG8_STAGE(PG8_SA(0, 1), a2 + hstep, voffA);
            PG8_WAIT_V(8); PG8_WAIT_L(0); PG8_BAR; PG8_MMA(0, 0, At, B0); PG8_MMA(0, 1, At, B1); PG8_BAR; PG8_SCHED;
            PG8_LDA(At, 1, 1); PG8_STAGE(PG8_SB(1, 0), b3, voffB); PG8_STAGE(PG8_SB(1, 1), b3 + hstep, voffB); PG8_STAGE(PG8_SA(1, 0), a3, voffA);
            PG8_WAIT_V(8); PG8_WAIT_L(0); PG8_BAR; PG8_MMA(1, 0, At, B0); PG8_MMA(1, 1, At, B1); PG8_BAR; PG8_SCHED;
            } else {
            PG8_LDB(B0, 0, 0); PG8_SCHED; PG8_LDA(At, 0, 0); PG8_STAGE(PG8_SA(1, 1), a1 + hstep, voffA);
            PG8_WAIT_L(8); PG8_BAR; PG8_WAIT_L(0); PG8_MMA(0, 0, At, B0); PG8_BAR; PG8_SCHED;
            PG8_LDB(B1, 0, 1); PG8_STAGE(PG8_SB(0, 0), b2, voffB);
            PG8_BAR; PG8_WAIT_L(0); PG8_MMA(0, 1, At, B1); PG8_BAR;
            PG8_LDA(At, 0, 1); PG8_STAGE(PG8_SA(0, 0), a2, voffA);
            PG8_BAR; PG8_WAIT_L(0); PG8_MMA(1, 0, At, B0); PG8_BAR; PG8_SCHED;
            PG8_STAGE(PG8_SB(0, 1), b2 + hstep, voffB);
            PG8_WAIT_V(6); PG8_BAR; PG8_MMA(1, 1, At, B1); PG8_BAR;
            PG8_LDB(B0, 1, 0); PG8_SCHED; PG8_LDA(At, 1, 0); PG8_STAGE(PG8_SA(0, 1), a2 + hstep, voffA);
            PG8_WAIT_L(8); PG8_BAR; PG8_WAIT_L(0); PG8_MMA(0, 0, At, B0); PG8_BAR; PG8_SCHED;
            PG8_LDB(B1, 1, 1); PG8_STAGE(PG8_SB(1, 0), b3, voffB);
            PG8_BAR; PG8_WAIT_L(0); PG8_MMA(0, 1, At, B1); PG8_BAR;
            PG8_LDA(At, 1, 1); PG8_STAGE(PG8_SA(1, 0), a3, voffA);
            PG8_BAR; PG8_WAIT_L(0); PG8_MMA(1, 0, At, B0); PG8_BAR; PG8_SCHED;
            PG8_STAGE(PG8_SB(1, 1), b3 + hstep, voffB);
            PG8_WAIT_V(6); PG8_BAR; PG8_MMA(1, 1, At, B1); PG8_BAR;
            }
        }
        if constexpr (ALIGN_EPI) { if (wr == 0) PG8_BAR; }
        if constexpr (!Epi::AFTER_DRAIN) { E(acc, cur, wr, wc, fr, fq); S.done(cur); }
        if (!has_next) break;
#pragma unroll
        for (int a = 0; a < 2; ++a)
#pragma unroll
            for (int b = 0; b < 2; ++b)
#pragma unroll
                for (int m = 0; m < 4; ++m)
#pragma unroll
                    for (int n = 0; n < 2; ++n) acc[a][b][m][n] = (f32x4){0.f, 0.f, 0.f, 0.f};
        cur = nxt; cA = nA; cB = nB; ++ui;
        if constexpr (ALIGN_EPI) { if (wr == 1) PG8_BAR; }
    }
    PG8_WAIT_V(0);
    if constexpr (!ALIGN_EPI) { if (wr == 0) PG8_BAR; }
    PG8_BAR;
    if constexpr (Epi::AFTER_DRAIN) { E.fused(acc, cur, wr, wc, fr, fq, lds, wid, lane); S.done(cur); }
#undef PG8_SA
#undef PG8_SB
#undef PG8_STAGE
#undef PG8_LDA
#undef PG8_LDB
#undef PG8_MMA
#undef PG8_WAIT_V
#undef PG8_WAIT_L
#undef PG8_BAR
#undef PG8_SCHED
}
}

#define LAS __attribute__((address_space(3)))
typedef unsigned short bf16;
typedef float f32x4 __attribute__((ext_vector_type(4)));
typedef float f32x16 __attribute__((ext_vector_type(16)));
typedef short bf16x8 __attribute__((ext_vector_type(8)));
typedef short s16x4 __attribute__((ext_vector_type(4)));
typedef unsigned u32x2 __attribute__((ext_vector_type(2)));
typedef unsigned u32x4 __attribute__((ext_vector_type(4)));

constexpr int NWAVES = 8, NTHR = 512;
constexpr int BATCH = 4, SEQ = 4096, D = 2048, M = BATCH * SEQ, FF = 5632, NH = 16, HD = 128, NQKV = 3 * D;
constexpr float RMS_EPS = 1e-6f;
constexpr float LOG2E = 1.44269504089f;
constexpr float SC2 = 0.08838834764831845f * LOG2E;

constexpr size_t SZ_W1 = (size_t)2 * FF * D * 2, SZ_W2 = (size_t)D * FF * 2, SZ_WQKV = (size_t)NQKV * D * 2, SZ_WO = (size_t)D * D * 2;
constexpr size_t WS_W1 = 0, WS_W2 = WS_W1 + 4 * SZ_W1, WS_WQKV = WS_W2 + 4 * SZ_W2, WS_WO = WS_WQKV + 2 * SZ_WQKV;
constexpr size_t WS_U = WS_WO + 2 * SZ_WO;
constexpr size_t WS_BIG = WS_U + (size_t)M * D * 2;
constexpr size_t WS_O = WS_BIG + (size_t)M * NQKV * 2;
constexpr size_t WS_LSE = WS_O + (size_t)M * D * 2;
constexpr size_t WS_KMH = WS_LSE + (size_t)3 * M * 8 * 4;
constexpr size_t WS_KML = WS_KMH + (size_t)4 * BATCH * 8 * 16 * 128 * 4;
constexpr size_t WS_BIAS = WS_KML + (size_t)BATCH * 8 * 16 * 128 * 2;
constexpr size_t WS_BKT = WS_BIAS + (size_t)16 * 4096 * 4;
constexpr size_t WS_SS = WS_BKT + 4096;
constexpr size_t WS_KT = WS_SS + (size_t)7 * M * 32 * 4;
constexpr size_t WS_CTL = WS_KT + (size_t)M * D * 2;
constexpr size_t CTL_BYTES = 16384;
constexpr size_t WS_END = WS_CTL + CTL_BYTES;

constexpr int LDS_BYTES = 155648 + 64 + 1024;
#ifndef REP_GEMM
#define REP_GEMM 1
#endif
#ifndef REP_P0
#define REP_P0 1
#endif
#ifndef REP_NORM
#define REP_NORM 1
#endif
#ifndef REP_DIL
#define REP_DIL 1
#endif
#ifndef REP_MOBA
#define REP_MOBA 1
#endif
#ifndef REP_SB
#define REP_SB 1
#endif

struct Args { const float* in[11]; float* out; unsigned char* ws; };

__device__ __forceinline__ float wave_sum(float v) {
#pragma unroll
    for (int o = 1; o < 64; o <<= 1) v += __shfl_xor(v, o);
    return v;
}
__device__ __forceinline__ unsigned cvtpk(float lo, float hi) { return pg8::cvt_pk_bf16(lo, hi); }
template <class T> __device__ __forceinline__ T* as_global(T* p) { return (T*)(__attribute__((address_space(1))) T*)p; }

__device__ __forceinline__ void tr_item(const float* __restrict__ W, int N, bf16* __restrict__ WT, int K, int k0, int n0, int drow0, int lane, const float* __restrict__ gain, int k0dst = -1  ) {
    const int c = lane & 7, n4 = lane >> 3;
    const float* src = W + (size_t)(k0 + 8 * c) * N + n0 + 4 * n4;
    f32x4 v[8];
#pragma unroll
    for (int j = 0; j < 8; ++j) v[j] = __builtin_nontemporal_load((const f32x4*)(src + (size_t)j * N));
    if (gain) {
        const f32x4 g0 = *(const f32x4*)(gain + k0 + 8 * c), g1 = *(const f32x4*)(gain + k0 + 8 * c + 4);
        v[0] *= g0[0]; v[1] *= g0[1]; v[2] *= g0[2]; v[3] *= g0[3]; v[4] *= g1[0]; v[5] *= g1[1]; v[6] *= g1[2]; v[7] *= g1[3]; }
    bf16* dst = WT + (size_t)(drow0 + 4 * n4) * K + (k0dst >= 0 ? k0dst : k0) + 8 * c;
#pragma unroll
    for (int e = 0; e < 4; ++e) {
        u32x4 o; o.x = cvtpk(v[0][e], v[1][e]); o.y = cvtpk(v[2][e], v[3][e]); o.z = cvtpk(v[4][e], v[5][e]); o.w = cvtpk(v[6][e], v[7][e]);
        *(u32x4*)(dst + (size_t)e * K) = o; }
}
__device__ __forceinline__ void p0_weights(const Args& a, int gw, int NGW, int lane) {
    constexpr int I_F = (D / 64) * (FF / 32);
    constexpr int I_Q = (D / 64) * (NQKV / 32);
    constexpr int I_O = (D / 64) * (D / 32);
    constexpr int NITEMS = 12 * I_F + 2 * I_Q + 2 * I_O;
    unsigned char* ws = as_global(a.ws);
    for (int it = gw; it < NITEMS; it += NGW) {
        if (it < 12 * I_F) {
            const int seg = it / I_F, r = it - seg * I_F, kind = seg >> 2, idx = seg & 3;
            if (kind < 2) {
                const float* W = as_global(a.in[2 + kind]) + (size_t)idx * D * FF;
                const int nnb = FF / 32, kb = r / nnb, nb = r - kb * nnb, n0 = nb * 32;
                tr_item(W, FF, (bf16*)(ws + WS_W1 + idx * SZ_W1), D, kb * 64, n0, (n0 >> 7) * 256 + kind * 128 + (n0 & 127), lane, as_global(a.in[1]) + (size_t)((idx >> 1) * 3 + (idx & 1) * 2) * D);
            } else {
                const float* W = as_global(a.in[4]) + (size_t)idx * FF * D;
                const int nnb = D / 32, kb = r / nnb, nb = r - kb * nnb, n0 = nb * 32;
                tr_item(W, D, (bf16*)(ws + WS_W2 + idx * SZ_W2), FF, kb * 64, n0, n0, lane, nullptr, (43 - ((kb * 64) >> 7)) * 128 + ((kb * 64) & 127));
            }
        } else {
            int r = it - 12 * I_F;
            if (r < 2 * I_Q) { const int l = r / I_Q; r -= l * I_Q; const float* W = as_global(a.in[l == 0 ? 5 : 7]);
                const int nnb = NQKV / 32, kb = r / nnb, nb = r - kb * nnb, n0 = nb * 32;
                tr_item(W, NQKV, (bf16*)(ws + WS_WQKV + l * SZ_WQKV), D, kb * 64, n0, n0, lane, as_global(a.in[1]) + (size_t)(l * 3 + 1) * D);
            } else { r -= 2 * I_Q; const int l = r / I_O; r -= l * I_O; const float* W = as_global(a.in[l == 0 ? 6 : 8]);
                const int nnb = D / 32, kb = r / nnb, nb = r - kb * nnb, n0 = nb * 32;
                tr_item(W, D, (bf16*)(ws + WS_WO + l * SZ_WO), D, kb * 64, n0, n0, lane, nullptr);
            }
        }
    }
}
__device__ __forceinline__ void p0_bias(const Args& a, int gtid, int gthreads) {
    float* bt = (float*)(as_global(a.ws) + WS_BIAS); const float* rb = as_global(a.in[9]);
    for (int i = gtid; i < 16 * 4096; i += gthreads) {
        const int h = i >> 12, d = i & 4095; int bk;
        if (d < 16) bk = d; else { const float df = (float)d; int lg = 16 + (int)(logf(df / 16.0f) / logf(128.0f) * 16.0f); bk = lg < 31 ? lg : 31; }
        bt[i] = rb[bk * 16 + h] * LOG2E;
        if (h == 0) (as_global(a.ws) + WS_BKT)[d] = (unsigned char)bk;
    }
}
template <bool TO_F32>
__device__ __forceinline__ void rms_row(const float* xrow, const float* g, void* orow, int lane) {
    const f32x4* xr = (const f32x4*)xrow + lane; const f32x4* gr = (const f32x4*)g + lane;
    f32x4 v[8]; float s = 0.f;
#pragma unroll
    for (int j = 0; j < 8; ++j) { v[j] = xr[64 * j]; s += (v[j].x * v[j].x + v[j].y * v[j].y) + (v[j].z * v[j].z + v[j].w * v[j].w); }
    const float rstd = 1.0f / sqrtf(wave_sum(s) * (1.0f / D) + RMS_EPS);
#pragma unroll
    for (int j = 0; j < 8; ++j) { const f32x4 gg = gr[64 * j]; const f32x4 y = v[j] * rstd * gg;
        if (TO_F32) ((f32x4*)orow)[lane + 64 * j] = y;
        else { u32x2 w; w.x = cvtpk(y.x, y.y); w.y = cvtpk(y.z, y.w); ((u32x2*)orow)[lane + 64 * j] = w; } }
}

__device__ __forceinline__ void x_row(const float* xrow, bf16* orow, float* ss, int lane) {
    const f32x4* xr = (const f32x4*)xrow + lane; float s = 0.f;
#pragma unroll
    for (int j = 0; j < 8; ++j) { const f32x4 v = xr[64 * j]; u32x2 w; w.x = cvtpk(v.x, v.y); w.y = cvtpk(v.z, v.w); ((u32x2*)orow)[lane + 64 * j] = w;
        const float r0 = __uint_as_float(w.x << 16), r1 = __uint_as_float(w.x & 0xffff0000u), r2 = __uint_as_float(w.y << 16), r3 = __uint_as_float(w.y & 0xffff0000u);
        s += (r0 * r0 + r1 * r1) + (r2 * r2 + r3 * r3); }
    s = wave_sum(s);
    if (lane < 32) ss[lane] = s * (1.0f / 32.0f);
}
__device__ __forceinline__ void final_row(float* orow, const bf16* hrow, const float* g, const float* ss, int lane) {
    const float rstd = 1.0f / sqrtf(wave_sum(lane < 32 ? ss[lane] : 0.f) * (1.0f / D) + RMS_EPS);
    f32x4* xr = (f32x4*)orow + lane; const f32x4* gr = (const f32x4*)g + lane; const u32x2* hr = (const u32x2*)hrow + lane;
#pragma unroll
    for (int j = 0; j < 8; ++j) { const u32x2 a = hr[64 * j]; f32x4 v;
        v.x = __uint_as_float(a.x << 16); v.y = __uint_as_float(a.x & 0xffff0000u); v.z = __uint_as_float(a.y << 16); v.w = __uint_as_float(a.y & 0xffff0000u);
        xr[64 * j] = v * rstd * gr[64 * j]; }
}

#define MFMA32(a, b, c) __builtin_amdgcn_mfma_f32_32x32x16_bf16(a, b, c, 0, 0, 0)
struct WCtx { int lane, q, h; LAS unsigned char* vbuf; unsigned wb[4]; unsigned trb0, trb1; };
__device__ __forceinline__ void wctx_init(WCtx& w, LAS unsigned char* vbuf, int lane) {
    w.lane = lane; w.q = lane & 31; w.h = lane >> 5; w.vbuf = vbuf;
    const int ch = lane & 15, kr = lane >> 4;
#pragma unroll
    for (int x = 0; x < 4; ++x) w.wb[x] = (unsigned)(512 * (ch >> 2) + 64 * kr + 16 * ((ch & 3) ^ x));
    const int qq = (lane & 15) >> 2, p = lane & 3, blk = (lane >> 4) & 1, h = lane >> 5;
    const int x0 = (2 * blk + (p >> 1)) ^ (2 * h);
    w.trb0 = (unsigned)(2048 * h + 64 * qq + 16 * x0 + 8 * (p & 1));
    w.trb1 = (unsigned)(2048 * h + 256 + 64 * qq + 16 * (x0 ^ 1) + 8 * (p & 1));
}
__device__ __forceinline__ void load_q(const bf16* qrow  , bf16x8 (&qf)[8]) {
#pragma unroll
    for (int s = 0; s < 8; ++s) qf[s] = *(const bf16x8*)(qrow + 16 * s);
}
__device__ __forceinline__ f32x16 qk_tile(const bf16* krow  , const bf16x8 (&qf)[8]) {
    bf16x8 kf[8];
#pragma unroll
    for (int s = 0; s < 8; ++s) kf[s] = *(const bf16x8*)(krow + 16 * s);
    f32x16 acc;
#pragma unroll
    for (int i = 0; i < 16; ++i) acc[i] = 0.f;
#pragma unroll
    for (int s = 0; s < 8; ++s) acc = MFMA32(kf[s], qf[s], acc);
    return acc;
}
__device__ __forceinline__ void load_v(const bf16* vt, size_t stride, const WCtx& w, u32x4 (&vr)[8]) {
    const bf16* p = vt + (size_t)(w.lane >> 4) * stride + (w.lane & 15) * 8;
#pragma unroll
    for (int i = 0; i < 8; ++i) vr[i] = *(const u32x4*)(p + (size_t)(4 * i) * stride);
}
__device__ __forceinline__ void stage_v(const WCtx& w, const u32x4 (&vr)[8]) {
#pragma unroll
    for (int i = 0; i < 8; ++i)
        *(LAS u32x4*)(w.vbuf + (2048 * ((i & 1) + 2 * (i >> 2)) + 256 * ((i >> 1) & 1)) + w.wb[((i >> 1) & 1) + 2 * (i & 1)]) = vr[i];
}
__device__ __forceinline__ void pv_tile(const WCtx& w, const bf16x8 (&pf)[2], f32x16 (&o)[4]) {
#pragma unroll
    for (int ks = 0; ks < 2; ++ks)
#pragma unroll
        for (int c = 0; c < 4; ++c) {
            const s16x4 lo = __builtin_amdgcn_ds_read_tr16_b64_v4i16((LAS s16x4*)(w.vbuf + w.trb0 + 4096 * ks + 512 * c));
            const s16x4 hi = __builtin_amdgcn_ds_read_tr16_b64_v4i16((LAS s16x4*)(w.vbuf + w.trb1 + 4096 * ks + 512 * c));
            bf16x8 a; a[0] = lo[0]; a[1] = lo[1]; a[2] = lo[2]; a[3] = lo[3]; a[4] = hi[0]; a[5] = hi[1]; a[6] = hi[2]; a[7] = hi[3];
            o[c] = MFMA32(a, pf[ks], o[c]);
        }
}
__device__ __forceinline__ void pv_tile_b(const LAS unsigned char* vimg, const WCtx& w, const bf16x8 (&pf)[2], f32x16 (&o)[4]) {
#pragma unroll
    for (int ks = 0; ks < 2; ++ks)
#pragma unroll
        for (int c = 0; c < 4; ++c) {
            const s16x4 lo = __builtin_amdgcn_ds_read_tr16_b64_v4i16((LAS s16x4*)(vimg + w.trb0 + 4096 * ks + 512 * c));
            const s16x4 hi = __builtin_amdgcn_ds_read_tr16_b64_v4i16((LAS s16x4*)(vimg + w.trb1 + 4096 * ks + 512 * c));
            bf16x8 a; a[0] = lo[0]; a[1] = lo[1]; a[2] = lo[2]; a[3] = lo[3]; a[4] = hi[0]; a[5] = hi[1]; a[6] = hi[2]; a[7] = hi[3];
            o[c] = MFMA32(a, pf[ks], o[c]);
        }
}
__device__ __forceinline__ void pack_p(const float (&p)[16], bf16x8 (&pf)[2]) {
#pragma unroll
    for (int ks = 0; ks < 2; ++ks) {
        u32x4 w; w.x = cvtpk(p[8 * ks + 0], p[8 * ks + 1]); w.y = cvtpk(p[8 * ks + 2], p[8 * ks + 3]); w.z = cvtpk(p[8 * ks + 4], p[8 * ks + 5]); w.w = cvtpk(p[8 * ks + 6], p[8 * ks + 7]);
        pf[ks] = __builtin_bit_cast(bf16x8, w); }
}
__device__ __forceinline__ float xh_max(float v) { const auto r = __builtin_amdgcn_permlane32_swap(__float_as_uint(v), __float_as_uint(v), false, false); return fmaxf(__uint_as_float(r[0]), __uint_as_float(r[1])); }
__device__ __forceinline__ float xh_sum(float v) { const auto r = __builtin_amdgcn_permlane32_swap(__float_as_uint(v), __float_as_uint(v), false, false); return __uint_as_float(r[0]) + __uint_as_float(r[1]); }
__device__ __forceinline__ float xh_other(float v, int h) { const auto r = __builtin_amdgcn_permlane32_swap(__float_as_uint(v), __float_as_uint(v), false, false); return __uint_as_float(h == 0 ? r[1] : r[0]); }
__device__ __forceinline__ void softmax_step(const float (&s)[16], float& m, float& l, f32x16 (&o)[4], bf16x8 (&pf)[2]) {
    float mx = s[0];
#pragma unroll
    for (int i = 1; i < 16; ++i) mx = fmaxf(mx, s[i]);
    mx = xh_max(mx);
    const float mn = fmaxf(m, mx), mu = (mn == -INFINITY) ? 0.f : mn;
    const float alpha = __builtin_amdgcn_exp2f(m - mu);
    float p[16], ps = 0.f;
#pragma unroll
    for (int i = 0; i < 16; ++i) { p[i] = __builtin_amdgcn_exp2f(s[i] - mu); ps += p[i]; }
    l = l * alpha + ps; m = mn;
    if (__builtin_amdgcn_ballot_w64(alpha != 1.0f) != 0ull) {
#pragma unroll
        for (int c = 0; c < 4; ++c)
#pragma unroll
            for (int i = 0; i < 16; ++i) o[c][i] *= alpha; }
    pack_p(p, pf);
}
__device__ __forceinline__ void write_o(const f32x16 (&o)[4], float mul, bf16* orow, int h) {
#pragma unroll
    for (int c = 0; c < 4; ++c)
#pragma unroll
        for (int g = 0; g < 4; ++g) { u32x2 w; w.x = cvtpk(o[c][4 * g] * mul, o[c][4 * g + 1] * mul); w.y = cvtpk(o[c][4 * g + 2] * mul, o[c][4 * g + 3] * mul);
            *(u32x2*)(orow + 32 * c + 8 * g + 4 * h) = w; }
}
#define ZERO_O(o) do { _Pragma("unroll") for (int c_ = 0; c_ < 4; ++c_) _Pragma("unroll") for (int i_ = 0; i_ < 16; ++i_) o[c_][i_] = 0.f; } while (0)

__device__ __forceinline__ void load_k(const bf16* krow  , bf16x8 (&kf)[8]) {
#pragma unroll
    for (int s = 0; s < 8; ++s) kf[s] = *(const bf16x8*)(krow + 16 * s);
}
__device__ __forceinline__ void load_kt(const bf16* kt  , bf16x8 (&kf)[8]) {
#pragma unroll
    for (int s = 0; s < 8; ++s) kf[s] = *(const bf16x8*)(kt + 512 * s);
}
__device__ __forceinline__ f32x16 qk_mma(const bf16x8 (&kf)[8], const bf16x8 (&qf)[8]) {
    f32x16 acc;
#pragma unroll
    for (int i = 0; i < 16; ++i) acc[i] = 0.f;
#pragma unroll
    for (int s = 0; s < 8; ++s) acc = MFMA32(kf[s], qf[s], acc);
    return acc;
}
__device__ __forceinline__ void load_vp(const bf16* p  , size_t stride, u32x4 (&vr)[8]) {
#pragma unroll
    for (int i = 0; i < 8; ++i) vr[i] = *(const u32x4*)(p + (size_t)(4 * i) * stride);
}

__device__ __forceinline__ void stage_k(LAS unsigned char* kimg, int lane, const u32x4 (&kr)[8]) {
    LAS unsigned char* p = kimg + ((unsigned)lane & 15u) * 528u + ((unsigned)lane >> 4) * 16u;
#pragma unroll
    for (int i = 0; i < 8; ++i) *(LAS u32x4*)(p + 64 * i) = kr[i];
}
__device__ __forceinline__ f32x16 qk_mma_img(const LAS unsigned char* kimg, int lane, const bf16x8 (&qf)[8]) {
    const LAS unsigned char* p = kimg + ((unsigned)lane >> 5) * 528u + ((unsigned)lane & 31u) * 16u;
    bf16x8 kf[8];
#pragma unroll
    for (int s = 0; s < 8; ++s) kf[s] = *(const LAS bf16x8*)(p + 1056 * s);
    return qk_mma(kf, qf);
}

#define PIN16(a) asm volatile("" : "+v"(a[0]), "+v"(a[1]), "+v"(a[2]), "+v"(a[3]), "+v"(a[4]), "+v"(a[5]), "+v"(a[6]), "+v"(a[7]), "+v"(a[8]), "+v"(a[9]), "+v"(a[10]), "+v"(a[11]), "+v"(a[12]), "+v"(a[13]), "+v"(a[14]), "+v"(a[15]))
__device__ __forceinline__ void dilated_wave(const bf16* qkv, int b, int head, int r, int c, int l0, bf16* obase, int o_ld, float* lse_out, const LAS float* btab, LAS unsigned char* kimg  , const WCtx& w) {
    const size_t tokq = (size_t)b * SEQ + (size_t)(l0 + w.q) * r + c;
    bf16x8 qf[8]; load_q(qkv + tokq * NQKV + head * HD + 8 * w.h, qf);
    f32x16 o[4]; ZERO_O(o); float m = -INFINITY, l = 0.f;
    const size_t vstride = (size_t)r * NQKV, tstep = 32 * vstride;
    int j = l0 >= 128 ? 0 : (128 - l0) >> 5;
    const size_t tok0 = (size_t)b * SEQ + (size_t)(l0 - 128 + 32 * j) * r + c;
    const bf16* vp = qkv + (tok0 + (size_t)(w.lane >> 4) * r) * NQKV + 2 * D + head * HD + (w.lane & 15) * 8;
    const bf16* kp = vp - D;
    u32x4 kr[8]; u32x4 vr[8]; load_vp(kp, vstride, kr); load_vp(vp, vstride, vr);
#pragma unroll 1
    for (;;) {
        stage_k(kimg, w.lane, kr);
        const f32x16 acc = qk_mma_img(kimg, w.lane, qf);
        const bool more = j < 4;
        if (more) { kp += tstep; load_vp(kp, vstride, kr); }
        float s[16], bv[16];
#pragma unroll
        for (int i = 0; i < 16; ++i) { const int kk = 8 * (i >> 2) + 4 * w.h + (i & 3); const int rel = 128 - 32 * j + w.q - kk;
            bv[i] = btab[min(max(rel, 0), 128) * r]; }
        PIN16(bv);
#pragma unroll
        for (int i = 0; i < 16; ++i) { const int kk = 8 * (i >> 2) + 4 * w.h + (i & 3);
            const bool valid = ((j != 0) | (kk >= w.q)) & ((j != 4) | (kk <= w.q));
            s[i] = fminf(acc[i] * SC2 + bv[i], valid ? INFINITY : -INFINITY); }
        bf16x8 pf[2]; softmax_step(s, m, l, o, pf);
        stage_v(w, vr);
        pv_tile(w, pf, o);
        if (!more) break;
        vp += tstep; load_vp(vp, vstride, vr);
        ++j;
    }
    const float lt = xh_sum(l), inv = 1.0f / lt;
    write_o(o, inv, obase + tokq * o_ld + head * HD, w.h);
    if (w.h == 0) lse_out[tokq * 8 + head] = m + __builtin_amdgcn_logf(lt);
}

__device__ __forceinline__ void moba_wave(const bf16* qkv, const bf16* KT, const float* kmq, int b, int hh, int t0, bf16* O, const LAS float* btab, const LAS unsigned char* bkt, const WCtx& w) {
    const int head = 8 + hh, own = t0 >> 8;
    const size_t tokq = (size_t)b * SEQ + t0 + w.q;
    bf16x8 qf[8]; load_q(qkv + tokq * NQKV + head * HD + 8 * w.h, qf);
    unsigned sel = (1u << own) - 1u;
    if (own > 3) {
        const int n = w.q & 15; const size_t ko = ((size_t)(b * 8 + hh) * 16 + n) * HD + 8 * w.h; constexpr size_t QS = (size_t)BATCH * 8 * 16 * HD;
        f32x16 g;
#pragma unroll
        for (int i = 0; i < 16; ++i) g[i] = 0.f;
#pragma unroll
        for (int s = 0; s < 8; ++s) {
            f32x4 a0 = *(const f32x4*)(kmq + ko + 16 * s), a1 = *(const f32x4*)(kmq + ko + 16 * s + 4);
#pragma unroll
            for (int qd = 1; qd < 4; ++qd) { a0 += *(const f32x4*)(kmq + qd * QS + ko + 16 * s); a1 += *(const f32x4*)(kmq + qd * QS + ko + 16 * s + 4); }
            a0 *= (1.0f / 256.0f); a1 *= (1.0f / 256.0f);
            u32x4 hi; hi.x = cvtpk(a0[0], a0[1]); hi.y = cvtpk(a0[2], a0[3]); hi.z = cvtpk(a1[0], a1[1]); hi.w = cvtpk(a1[2], a1[3]);
            u32x4 lo; lo.x = cvtpk(a0[0] - __uint_as_float(hi.x << 16), a0[1] - __uint_as_float(hi.x & 0xffff0000u)); lo.y = cvtpk(a0[2] - __uint_as_float(hi.y << 16), a0[3] - __uint_as_float(hi.y & 0xffff0000u));
            lo.z = cvtpk(a1[0] - __uint_as_float(hi.z << 16), a1[1] - __uint_as_float(hi.z & 0xffff0000u)); lo.w = cvtpk(a1[2] - __uint_as_float(hi.w << 16), a1[3] - __uint_as_float(hi.w & 0xffff0000u));
            g = MFMA32(__builtin_bit_cast(bf16x8, hi), qf[s], g); g = MFMA32(__builtin_bit_cast(bf16x8, lo), qf[s], g); }
        float pg[8], gv[16];
#pragma unroll
        for (int i = 0; i < 8; ++i) pg[i] = xh_other(g[i], w.h);
#pragma unroll
        for (int nn = 0; nn < 16; ++nn) { const int a = nn >> 3, bb = (nn >> 2) & 1, e = nn & 3; const float v = (bb == w.h) ? g[4 * a + e] : pg[4 * a + e]; gv[nn] = (nn < own) ? v : -INFINITY; }
        sel = 0u;
#pragma unroll
        for (int rd = 0; rd < 3; ++rd) { float best = -INFINITY; int bi = 0;
#pragma unroll
            for (int nn = 0; nn < 16; ++nn) { const bool take = !((sel >> nn) & 1u) && (gv[nn] > best); best = take ? gv[nn] : best; bi = take ? nn : bi; }
            sel |= 1u << bi; }
    }
    unsigned bm = 1u << own;
#pragma unroll
    for (int n = 0; n < 15; ++n) if (__builtin_amdgcn_ballot_w64((sel >> n) & 1u) != 0ull) bm |= 1u << n;
    const int jd = (t0 & 255) >> 5;
    f32x16 o[4]; ZERO_O(o); float m = -INFINITY, l = 0.f;
    const bf16* kb = KT + ((size_t)((b * 16 + head) * 128) << 12) + w.lane * 8;
    const bf16* vb = qkv + ((size_t)b * SEQ + (w.lane >> 4)) * NQKV + 2 * D + head * HD + (w.lane & 15) * 8;
    int nb = __builtin_ctz(bm), jj = 0;
    bf16x8 kf[8]; u32x4 vr[8];
    { load_kt(kb + ((size_t)(nb * 8) << 12), kf); load_vp(vb + (size_t)(nb * 256) * NQKV, NQKV, vr); }
#pragma unroll 1
    for (;;) {
        const f32x16 acc = qk_mma(kf, qf);
        int nb2 = nb, jj2 = jj + 1; unsigned bm2 = bm;
        if (jj2 > (nb == own ? jd : 7)) { bm2 &= bm2 - 1u; jj2 = 0; nb2 = bm2 ? __builtin_ctz(bm2) : 0; }
        const bool more = bm2 != 0u;
        const size_t ko2 = (size_t)(nb2 * 256 + 32 * jj2) * NQKV;
        if (more) load_kt(kb + ((size_t)(nb2 * 8 + jj2) << 12), kf);
        const int key0 = nb * 256 + 32 * jj, dq = t0 - key0 + w.q - 4 * w.h;
        const bool rowsel = (nb == own) || ((sel >> nb) & 1u);
        float s[16];
        const int dlt = t0 - key0;
        bool uni = false;
        if (dlt >= 31) uni = __builtin_amdgcn_readfirstlane((int)bkt[dlt - 31]) == __builtin_amdgcn_readfirstlane((int)bkt[dlt + 31]);
        if (uni) {
            const float bu = btab[dlt], lim = rowsel ? INFINITY : -INFINITY;
#pragma unroll
            for (int i = 0; i < 16; ++i) s[i] = fminf(acc[i] * SC2 + bu, lim);
        } else {
#pragma unroll
            for (int i = 0; i < 16; ++i) { const int dist = dq - (8 * (i >> 2) + (i & 3)); const bool valid = rowsel && dist >= 0; const float v = acc[i] * SC2 + btab[max(dist, 0)]; s[i] = fminf(v, valid ? INFINITY : -INFINITY); }
        }
        bf16x8 pf[2]; softmax_step(s, m, l, o, pf);
        stage_v(w, vr);
        pv_tile(w, pf, o);
        if (!more) break;
        load_vp(vb + ko2, NQKV, vr);
        nb = nb2; jj = jj2; bm = bm2;
    }
    const float lt = xh_sum(l), inv = 1.0f / lt;
    write_o(o, inv, O + tokq * D + head * HD, w.h);
}

__device__ __forceinline__ void moba_logits(const f32x16& acc, int t0, int key0, bool rowsel, const LAS float* btab, const LAS unsigned char* bkt, const WCtx& w, float (&s)[16]) {
    const int dlt = t0 - key0, dq = dlt + w.q - 4 * w.h;
    bool uni = false;
    if (dlt >= 31) uni = __builtin_amdgcn_readfirstlane((int)bkt[dlt - 31]) == __builtin_amdgcn_readfirstlane((int)bkt[dlt + 31]);
    if (uni) {
        const float bu = btab[dlt], lim = rowsel ? INFINITY : -INFINITY;
#pragma unroll
        for (int i = 0; i < 16; ++i) s[i] = fminf(acc[i] * SC2 + bu, lim);
    } else {
        float bv[16];
#pragma unroll
        for (int i = 0; i < 16; ++i) bv[i] = btab[max(dq - (8 * (i >> 2) + (i & 3)), 0)];
        PIN16(bv);
#pragma unroll
        for (int i = 0; i < 16; ++i) { const int dist = dq - (8 * (i >> 2) + (i & 3)); const bool valid = rowsel && dist >= 0; s[i] = fminf(acc[i] * SC2 + bv[i], valid ? INFINITY : -INFINITY); }
    }
}
__device__ __forceinline__ void softmax_step2(const float (&sa)[16], const float (&sb)[16], float& m, float& l, f32x16 (&o)[4], bf16x8 (&pfa)[2], bf16x8 (&pfb)[2]) {
    float mx = fmaxf(sa[0], sb[0]);
#pragma unroll
    for (int i = 1; i < 16; ++i) mx = fmaxf(mx, fmaxf(sa[i], sb[i]));
    mx = xh_max(mx);
    const float mn = fmaxf(m, mx), mu = (mn == -INFINITY) ? 0.f : mn;
    const float alpha = __builtin_amdgcn_exp2f(m - mu);
    float pa[16], pb[16], ps = 0.f;
#pragma unroll
    for (int i = 0; i < 16; ++i) { pa[i] = __builtin_amdgcn_exp2f(sa[i] - mu); pb[i] = __builtin_amdgcn_exp2f(sb[i] - mu); ps += pa[i] + pb[i]; }
    l = l * alpha + ps; m = mn;
    if (__builtin_amdgcn_ballot_w64(alpha != 1.0f) != 0ull) {
#pragma unroll
        for (int c = 0; c < 4; ++c)
#pragma unroll
            for (int i = 0; i < 16; ++i) o[c][i] *= alpha; }
    pack_p(pa, pfa); pack_p(pb, pfb);
}

__device__ __forceinline__ void moba_wg(const bf16* qkv, const bf16* KT, const float* kmq, int b, int hh, int own, int wave, int tid, bf16* O, const LAS float* btab, const LAS unsigned char* bkt, LAS unsigned char* lds, const WCtx& w) {
    const int head = 8 + hh, t0 = own * 256 + wave * 32;
    const size_t tokq = (size_t)b * SEQ + t0 + w.q;
    bf16x8 qf[8]; load_q(qkv + tokq * NQKV + head * HD + 8 * w.h, qf);
    unsigned sel = (1u << own) - 1u;
    if (own > 3) {
        const int n = w.q & 15; const size_t ko = ((size_t)(b * 8 + hh) * 16 + n) * HD + 8 * w.h; constexpr size_t QS = (size_t)BATCH * 8 * 16 * HD;
        f32x16 g;
#pragma unroll
        for (int i = 0; i < 16; ++i) g[i] = 0.f;
#pragma unroll
        for (int s = 0; s < 8; ++s) {
            f32x4 a0 = *(const f32x4*)(kmq + ko + 16 * s), a1 = *(const f32x4*)(kmq + ko + 16 * s + 4);
#pragma unroll
            for (int qd = 1; qd < 4; ++qd) { a0 += *(const f32x4*)(kmq + qd * QS + ko + 16 * s); a1 += *(const f32x4*)(kmq + qd * QS + ko + 16 * s + 4); }
            a0 *= (1.0f / 256.0f); a1 *= (1.0f / 256.0f);
            u32x4 hi; hi.x = cvtpk(a0[0], a0[1]); hi.y = cvtpk(a0[2], a0[3]); hi.z = cvtpk(a1[0], a1[1]); hi.w = cvtpk(a1[2], a1[3]);
            u32x4 lo; lo.x = cvtpk(a0[0] - __uint_as_float(hi.x << 16), a0[1] - __uint_as_float(hi.x & 0xffff0000u)); lo.y = cvtpk(a0[2] - __uint_as_float(hi.y << 16), a0[3] - __uint_as_float(hi.y & 0xffff0000u));
            lo.z = cvtpk(a1[0] - __uint_as_float(hi.z << 16), a1[1] - __uint_as_float(hi.z & 0xffff0000u)); lo.w = cvtpk(a1[2] - __uint_as_float(hi.w << 16), a1[3] - __uint_as_float(hi.w & 0xffff0000u));
            g = MFMA32(__builtin_bit_cast(bf16x8, hi), qf[s], g); g = MFMA32(__builtin_bit_cast(bf16x8, lo), qf[s], g); }
        float pg[8], gv[16];
#pragma unroll
        for (int i = 0; i < 8; ++i) pg[i] = xh_other(g[i], w.h);
#pragma unroll
        for (int nn = 0; nn < 16; ++nn) { const int a = nn >> 3, bb = (nn >> 2) & 1, e = nn & 3; const float v = (bb == w.h) ? g[4 * a + e] : pg[4 * a + e]; gv[nn] = (nn < own) ? v : -INFINITY; }
        sel = 0u;
#pragma unroll
        for (int rd = 0; rd < 3; ++rd) { float best = -INFINITY; int bi = 0;
#pragma unroll
            for (int nn = 0; nn < 16; ++nn) { const bool take = !((sel >> nn) & 1u) && (gv[nn] > best); best = take ? gv[nn] : best; bi = take ? nn : bi; }
            sel |= 1u << bi; }
    }
    unsigned bmw = 1u << own;
#pragma unroll
    for (int n = 0; n < 15; ++n) if (__builtin_amdgcn_ballot_w64((sel >> n) & 1u) != 0ull) bmw |= 1u << n;
    LAS unsigned* wgw = (LAS unsigned*)(lds + 86016);
    if (tid == 0) wgw[0] = 0u;
    __syncthreads();
    if (w.lane == 0) __hip_atomic_fetch_or(wgw, bmw, __ATOMIC_RELAXED, __HIP_MEMORY_SCOPE_WORKGROUP);
    __syncthreads();
    unsigned bm = (unsigned)__builtin_amdgcn_readfirstlane((int)wgw[0]);
    f32x16 o[4]; ZERO_O(o); float m = -INFINITY, l = 0.f;
    const bf16* kg = KT + ((size_t)((b * 16 + head) * 128) << 12) + tid * 8;
    const bf16* vg = qkv + ((size_t)b * SEQ + (tid >> 4)) * NQKV + 2 * D + head * HD + (tid & 15) * 8;
    const unsigned kst = (unsigned)tid * 16u;
    unsigned vst; { const int kr = w.lane >> 4, ch = w.lane & 15, x = ((wave >> 1) & 1) + 2 * (wave & 1);
        vst = (unsigned)(8192 + 2048 * ((wave & 1) + 2 * (wave >> 2)) + 256 * ((wave >> 1) & 1) + 512 * (ch >> 2) + 64 * kr + 16 * ((ch & 3) ^ x)); }
    int nb = __builtin_ctz(bm), u = 0, buf = 0;
    u32x4 kra, vra, krb, vrb;
    { const size_t t = (size_t)(nb * 8); const size_t k0 = (size_t)(nb * 256) * NQKV;
      kra = *(const u32x4*)(kg + (t << 12)); krb = *(const u32x4*)(kg + ((t + 1) << 12)); vra = *(const u32x4*)(vg + k0); vrb = *(const u32x4*)(vg + k0 + (size_t)32 * NQKV); }
    *(LAS u32x4*)(lds + kst) = kra; *(LAS u32x4*)(lds + vst) = vra; *(LAS u32x4*)(lds + 16384 + kst) = krb; *(LAS u32x4*)(lds + 16384 + vst) = vrb;
    __syncthreads();
#pragma unroll 1
    for (;;) {
        int nb2 = nb, u2 = u + 1; unsigned bm2 = bm;
        if (u2 > 3) { bm2 &= bm2 - 1u; u2 = 0; nb2 = bm2 ? __builtin_ctz(bm2) : 0; }
        const bool more = bm2 != 0u;
        if (more) { const size_t t = (size_t)(nb2 * 8 + 2 * u2); const size_t k0 = (size_t)(nb2 * 256 + 64 * u2) * NQKV;
            kra = *(const u32x4*)(kg + (t << 12)); krb = *(const u32x4*)(kg + ((t + 1) << 12)); vra = *(const u32x4*)(vg + k0); vrb = *(const u32x4*)(vg + k0 + (size_t)32 * NQKV); }
        const bool mine = ((bmw >> nb) & 1u) && (nb != own || 2 * u <= wave);
        if (mine) {
            const LAS unsigned char* base = lds + buf * 32768;
            const LAS unsigned char* kimg = base + w.lane * 16;
            bf16x8 kfa[8], kfb[8];
#pragma unroll
            for (int s = 0; s < 8; ++s) { kfa[s] = *(const LAS bf16x8*)(kimg + 1024 * s); kfb[s] = *(const LAS bf16x8*)(kimg + 16384 + 1024 * s); }
            f32x16 acca, accb;
#pragma unroll
            for (int i = 0; i < 16; ++i) { acca[i] = 0.f; accb[i] = 0.f; }
#pragma unroll
            for (int s = 0; s < 8; ++s) { acca = MFMA32(kfa[s], qf[s], acca); accb = MFMA32(kfb[s], qf[s], accb); }
            const int key0 = nb * 256 + 64 * u;
            const bool rowsel = (nb == own) || ((sel >> nb) & 1u);
            float sa[16], sb[16];
            moba_logits(acca, t0, key0, rowsel, btab, bkt, w, sa);
            moba_logits(accb, t0, key0 + 32, rowsel, btab, bkt, w, sb);
            bf16x8 pfa[2], pfb[2]; softmax_step2(sa, sb, m, l, o, pfa, pfb);
            pv_tile_b(base + 8192, w, pfa, o);
            pv_tile_b(base + 16384 + 8192, w, pfb, o);
        }
        if (more) { LAS unsigned char* nb_ = lds + (buf ^ 1) * 32768;
            *(LAS u32x4*)(nb_ + kst) = kra; *(LAS u32x4*)(nb_ + vst) = vra; *(LAS u32x4*)(nb_ + 16384 + kst) = krb; *(LAS u32x4*)(nb_ + 16384 + vst) = vrb; }
        __syncthreads();
        if (!more) break;
        nb = nb2; u = u2; bm = bm2; buf ^= 1;
    }
    const float lt = xh_sum(l), inv = 1.0f / lt;
    write_o(o, inv, O + tokq * D + head * HD, w.h);
}

__device__ __forceinline__ void sb_wave(const bf16* qkv, const bf16* KT, int b, int head, int t0, bf16* O, const WCtx& w) {
    const size_t tokq = (size_t)b * SEQ + t0 + w.q;
    bf16x8 qf[8]; load_q(qkv + tokq * NQKV + head * HD + 8 * w.h, qf);
    f32x16 o[4]; ZERO_O(o); float carry = 0.f;
    const bf16* kp = KT + ((size_t)((b * 16 + head) * 128 + (t0 >> 5)) << 12) + w.lane * 8;
    const bf16* vp = qkv + ((size_t)b * SEQ + t0 + (w.lane >> 4)) * NQKV + 2 * D + head * HD + (w.lane & 15) * 8;
    bf16x8 kf[8]; u32x4 vr[8]; load_kt(kp, kf); load_vp(vp, NQKV, vr);
    int kt = t0 >> 5; const int ktd = kt;
#pragma unroll 1
    for (;;) {
        const f32x16 acc = qk_mma(kf, qf);
        const bool diag = (kt == ktd), notlast = kt > 0;
        if (notlast) { kp -= 4096; load_kt(kp, kf); }
        float lk[16], ls[16];
#pragma unroll
        for (int i = 0; i < 16; ++i) { const int kk = 8 * (i >> 2) + 4 * w.h + (i & 3); const bool past = !diag || (kk < w.q);
            const float z = acc[i] * SC2, az = fabsf(z), e = __builtin_amdgcn_exp2f(-az), L = __builtin_amdgcn_logf(1.0f + e);
            lk[i] = past ? -(fmaxf(z, 0.f) + L) : 0.f; ls[i] = past ? (fminf(z, 0.f) - L) : -INFINITY; }
        float sg[4], pg[4];
#pragma unroll
        for (int g = 0; g < 4; ++g) { sg[g] = (lk[4 * g] + lk[4 * g + 1]) + (lk[4 * g + 2] + lk[4 * g + 3]); pg[g] = xh_other(sg[g], w.h); }
        float run = 0.f, p[16];
#pragma unroll
        for (int g = 3; g >= 0; --g) {
            float bt = carry + run + (w.h == 0 ? pg[g] : 0.f);
#pragma unroll
            for (int e = 3; e >= 0; --e) { p[4 * g + e] = __builtin_amdgcn_exp2f(ls[4 * g + e] + bt); bt += lk[4 * g + e]; }
            run += sg[g] + pg[g]; }
        carry += run;
        bf16x8 pf[2]; pack_p(p, pf);
        const bool more = notlast && (__builtin_amdgcn_ballot_w64(carry >= -170.0f) != 0ull);
        stage_v(w, vr);
        pv_tile(w, pf, o);
        if (!more) break;
        vp -= (size_t)32 * NQKV; load_vp(vp, NQKV, vr);
        --kt;
    }
    write_o(o, 1.0f, O + tokq * D + head * HD, w.h);
}

__device__ __forceinline__ void kmean_wave(const bf16* KT, float* kmq, int wt, int lane) {
    const int qd = wt & 3, n = (wt >> 2) & 15, hh = (wt >> 6) & 7, b = wt >> 9;
    const bf16* kp = KT + ((size_t)((b * 16 + 8 + hh) * 128 + n * 8 + qd * 2) << 12) + (lane >> 3) * 512 + ((lane >> 2) & 1) * 256 + 2 * (lane & 3);
    float s0 = 0.f, s1 = 0.f;
#pragma unroll 16
    for (int j = 0; j < 64; ++j) { const unsigned v = *(const unsigned*)(kp + (size_t)(j >> 5) * 4096 + (j & 31) * 8); s0 += __uint_as_float(v << 16); s1 += __uint_as_float(v & 0xffff0000u); }
    float* o = kmq + (size_t)qd * BATCH * 8 * 16 * HD + ((size_t)(b * 8 + hh) * 16 + n) * HD + 2 * lane;
    o[0] = s0; o[1] = s1;
}
__device__ __forceinline__ void combine_wave(bf16* O, const bf16* br1, const bf16* br2, const float* lse, int tok, int lane) {
    const int head = lane >> 3, d0 = (lane & 7) * 16;
    const float l0 = lse[(size_t)tok * 8 + head], l1 = lse[(size_t)M * 8 + (size_t)tok * 8 + head], l2 = lse[(size_t)2 * M * 8 + (size_t)tok * 8 + head];
    const float mx = fmaxf(l0, fmaxf(l1, l2)); float a0 = __builtin_amdgcn_exp2f(l0 - mx), a1 = __builtin_amdgcn_exp2f(l1 - mx), a2 = __builtin_amdgcn_exp2f(l2 - mx);
    const float inv = 1.0f / (a0 + a1 + a2); a0 *= inv; a1 *= inv; a2 *= inv;
    bf16* po = O + (size_t)tok * D + head * HD + d0; const bf16* p1 = br1 + (size_t)tok * 1024 + head * HD + d0; const bf16* p2 = br2 + (size_t)tok * 1024 + head * HD + d0;
#pragma unroll
    for (int k = 0; k < 2; ++k) {
        const u32x4 x0 = *(const u32x4*)(po + 8 * k), x1 = *(const u32x4*)(p1 + 8 * k), x2 = *(const u32x4*)(p2 + 8 * k); u32x4 y;
#pragma unroll
        for (int e = 0; e < 4; ++e) {
            const float lo = a0 * __uint_as_float(x0[e] << 16) + a1 * __uint_as_float(x1[e] << 16) + a2 * __uint_as_float(x2[e] << 16);
            const float hi = a0 * __uint_as_float(x0[e] & 0xffff0000u) + a1 * __uint_as_float(x1[e] & 0xffff0000u) + a2 * __uint_as_float(x2[e] & 0xffff0000u);
            y[e] = cvtpk(lo, hi); }
        *(u32x4*)(po + 8 * k) = y; }
}

template <class T> __device__ __forceinline__ T* opaque(T* p) {
    unsigned lo = __builtin_amdgcn_readfirstlane((unsigned)(unsigned long long)p), hi = __builtin_amdgcn_readfirstlane((unsigned)((unsigned long long)p >> 32));
    asm volatile("" : "+s"(lo), "+s"(hi)); return (T*)(__attribute__((address_space(1))) T*)(((unsigned long long)hi << 32) | lo); }
__device__ __forceinline__ int opaque_v(int v) { asm volatile("" : "+v"(v)); return v; }

#define RLX_AGENT __ATOMIC_RELAXED, __HIP_MEMORY_SCOPE_AGENT
#define XB_TMO      128
#define XB_XCNT(j)  (256  + 64 * (j))
#define XB_XSUB(j)  (1280 + 64 * (j))
#define XB_XGEN(j)  (2304 + 64 * (j))
#define XB_TOP      3328
#define XB_TOPGEN   3392
#define XCD_BAR_WORDS 3456
#define XB_SPIN_CAP (1u << 18)

__device__ __forceinline__ unsigned xb_ld(unsigned* p)              { return __hip_atomic_load(p, __ATOMIC_RELAXED, __HIP_MEMORY_SCOPE_AGENT); }
__device__ __forceinline__ unsigned xb_add(unsigned* p, unsigned v) { return __hip_atomic_fetch_add(p, v, __ATOMIC_RELAXED, __HIP_MEMORY_SCOPE_AGENT); }
__device__ __forceinline__ unsigned xb_xcc_id() { return (unsigned)__builtin_amdgcn_s_getreg((3 << 11) | 20) & 0xFu; }
#define XB_SPIN(cond, bar) do { unsigned _sp = 0; while (cond) { __builtin_amdgcn_s_sleep(1); \
    if ((++_sp & 255u) == 0u) { if (xb_ld(&(bar)[XB_TMO])) break; if (_sp > XB_SPIN_CAP) { atomicAdd(&(bar)[XB_TMO], 1u); break; } } } } while (0)

struct XcdBarrier {
    int wv;
    unsigned* bar; unsigned x;
    volatile LAS unsigned* st;
};

__device__ __forceinline__ XcdBarrier xcd_barrier_post(unsigned* bar, volatile LAS unsigned* st) {
    XcdBarrier b; b.wv = __builtin_amdgcn_readfirstlane((int)(threadIdx.x >> 6)); b.bar = bar; b.x = xb_xcc_id(); b.st = st;
    if (threadIdx.x == 0) (void)xb_add(&bar[XB_XCNT(b.x)], 1u);
    return b;
}
__device__ __forceinline__ void xcd_barrier_complete(unsigned* bar, unsigned x, unsigned& nloc, unsigned& nx) {
    const unsigned G = gridDim.x * gridDim.y * gridDim.z;
    unsigned sum, cnt, mine, sp = 0u;
    for (;;) {
        sum = 0u; cnt = 0u; mine = 0u;
#pragma unroll
        for (unsigned j = 0; j < 16; ++j) { const unsigned c = xb_ld(&bar[XB_XCNT(j)]); sum += c; cnt += (c > 0u) ? 1u : 0u; mine = (j == x) ? c : mine; }
        if (sum == G) break;
        __builtin_amdgcn_s_sleep(1);
        if ((++sp & 255u) == 0u) { if (xb_ld(&bar[XB_TMO])) break; if (sp > XB_SPIN_CAP) { atomicAdd(&bar[XB_TMO], 1u); break; } }
    }
    nloc = mine > 0u ? mine : 1u; nx = cnt > 0u ? cnt : 1u;
}

__device__ __forceinline__ void xcd_barrier(const XcdBarrier& b) {
    asm volatile("s_waitcnt vmcnt(0)" ::: "memory");
    __syncthreads();
    if (b.wv == 0 && pg8::lane_id() == 0) {
        unsigned* bar = b.bar;
        __builtin_amdgcn_s_waitcnt(0);
        unsigned nloc = b.st[0], nx = b.st[1];
        if (nloc == 0u) { xcd_barrier_complete(bar, b.x, nloc, nx); b.st[0] = nloc; b.st[1] = nx; }
        const unsigned old = xb_add(&bar[XB_XSUB(b.x)], 1u);
        const unsigned gen = old / nloc;
        if (old + 1u == (gen + 1u) * nloc) {
            __builtin_amdgcn_fence(__ATOMIC_RELEASE, "agent");
            asm volatile("s_waitcnt vmcnt(0)" ::: "memory");
            const unsigned og = xb_add(&bar[XB_TOP], 1u);
            const unsigned tg = og / nx;
            if (og + 1u == (tg + 1u) * nx) xb_add(&bar[XB_TOPGEN], 1u);
            else XB_SPIN(xb_ld(&bar[XB_TOPGEN]) == tg, bar);
            __builtin_amdgcn_fence(__ATOMIC_ACQUIRE, "agent");
            xb_add(&bar[XB_XGEN(b.x)], 1u);
            asm volatile("s_waitcnt vmcnt(0)" ::: "memory");
        } else {
            XB_SPIN(xb_ld(&bar[XB_XGEN(b.x)]) == gen, bar);
            __builtin_amdgcn_fence(__ATOMIC_ACQUIRE, "agent");
            asm volatile("s_waitcnt vmcnt(0)" ::: "memory");
        }
    }
    __syncthreads();
}


#define TIDX (wave_s * 64 + pg8::lane_id())
#ifndef REP_BAR
#define REP_BAR 1
#endif
#define STAMP() do { } while (0)
#define GRID_BAR() do { for (int rb_ = 0; rb_ < REP_BAR; ++rb_) xcd_barrier(bar); STAMP(); } while (0)
template <int s>
__device__ __forceinline__ void fwd_step(const Args& args, LAS unsigned char* lds, const XcdBarrier& bar, const int wave_s, const int cidx  ) {
        const int layer = s / 3, k3 = s - 3 * layer;
        if (k3 != 1) {
            const int widx = layer * 2 + (k3 >> 1);
            {
                unsigned char* ws = opaque(args.ws); const int G = gridDim.x, bx = blockIdx.x;
                pg8::Gemm g{(const bf16*)(ws + WS_U), (const bf16*)(ws + WS_W1 + widx * SZ_W1), M, 2 * FF, D}; pg8::StaticOrder S; S.init(M, 2 * FF, G, cidx);
                const float* ssp = (const float*)(ws + WS_SS) + (size_t)s * M * 32; LAS float* rt = (LAS float*)(lds + 155712);
                pg8::Unit u0; S.next(0, u0);
                { const int t_ = TIDX; if (t_ < 256) { const f32x4* pp = (const f32x4*)(ssp + (size_t)(u0.pm * 256 + t_) * 32); f32x4 a = pp[0];
#pragma unroll
                    for (int k = 1; k < 8; ++k) a += pp[k];
                    rt[t_] = __builtin_amdgcn_rsqf(((a.x + a.y) + (a.z + a.w)) * (1.0f / 2048.0f) + 1e-6f); } }
                __syncthreads();
                pg8::EpiSwiglu E{(bf16*)(ws + WS_BIG), FF, ssp, u0.pm};
                for (int rep = 0; rep < REP_GEMM; ++rep) { if (rep > 0) GRID_BAR(); pg8::gemm_phase<pg8::EpiSwiglu, pg8::StaticOrder, true, true>(lds, g, S, E, wave_s); }
            }
            GRID_BAR();
            {
                unsigned char* ws = opaque(args.ws); const int G = gridDim.x, bx = blockIdx.x; float* out = opaque(args.out);
                pg8::Gemm g{(const bf16*)(ws + WS_BIG), (const bf16*)(ws + WS_W2 + widx * SZ_W2), M, D, FF}; pg8::StaticOrder S; S.init(M, D, G, cidx);
                pg8::EpiResid E{(bf16*)(ws + WS_U), (float*)(ws + WS_SS) + (size_t)(s + 1) * M * 32, D, 0.5f};
                pg8::gemm_phase<pg8::EpiResid, pg8::StaticOrder, true, true>(lds, g, S, E, wave_s);
            }
            GRID_BAR();
        } else {
            {
                unsigned char* ws = opaque(args.ws); const int G = gridDim.x, bx = blockIdx.x;
                pg8::Gemm g{(const bf16*)(ws + WS_U), (const bf16*)(ws + WS_WQKV + layer * SZ_WQKV), M, NQKV, D}; pg8::StaticOrder S; S.init(M, NQKV, G, cidx);
                const float* ssp = (const float*)(ws + WS_SS) + (size_t)s * M * 32; LAS float* rt = (LAS float*)(lds + 155712);
                pg8::Unit u0; S.next(0, u0);
                { const int t_ = TIDX; if (t_ < 256) { const f32x4* pp = (const f32x4*)(ssp + (size_t)(u0.pm * 256 + t_) * 32); f32x4 a = pp[0];
#pragma unroll
                    for (int k = 1; k < 8; ++k) a += pp[k];
                    rt[t_] = __builtin_amdgcn_rsqf(((a.x + a.y) + (a.z + a.w)) * (1.0f / 2048.0f) + 1e-6f); } }
                __syncthreads();
                pg8::EpiQkv E{(bf16*)(ws + WS_BIG), NQKV, ssp, u0.pm, (bf16*)(ws + WS_KT), layer == 0 ? 12 : 8};
                for (int rep = 0; rep < REP_GEMM; ++rep) { if (rep > 0) GRID_BAR(); pg8::gemm_phase<pg8::EpiQkv, pg8::StaticOrder, true, true>(lds, g, S, E, wave_s); }
            }
            GRID_BAR();
            if (layer == 0) {
                {
                    unsigned char* ws = opaque(args.ws); const int G = gridDim.x, bx = blockIdx.x;
                    const int tid = opaque_v(TIDX), lane = tid & 63, wave = __builtin_amdgcn_readfirstlane(tid >> 6);
                    const bf16* BIG = (const bf16*)(ws + WS_BIG); bf16* OB = (bf16*)(ws + WS_O); bf16* BR1 = (bf16*)opaque(args.out); bf16* BR2 = BR1 + (size_t)M * 1024;
                    float* LSE = (float*)(ws + WS_LSE); const float* BIAS = (const float*)(ws + WS_BIAS);
                    LAS float* btab = (LAS float*)(lds + 133120);
                    WCtx w; wctx_init(w, lds + wave * 8192, lane);
                    int cur_head = -1;
                    for (int rep = 0; rep < REP_DIL; ++rep)
                    for (int task = bx; task < 1536; task += G) {
                        {
                            const int ri = task >> 9, rem = task & 511, b = rem >> 7, head = (rem >> 4) & 7, grp = rem & 15;
                            const int r = ri == 0 ? 1 : (ri == 1 ? 4 : 16), sh = ri == 0 ? 7 : (ri == 1 ? 5 : 3), wt = grp * 8 + wave, c = wt >> sh, l0 = (wt - (c << sh)) * 32;
                            if (head != cur_head) {
                                __syncthreads();
                                for (int i = tid; i < 2112; i += NTHR) btab[i] = BIAS[head * 4096 + i];
                                __syncthreads();
                                cur_head = head; }
                            bf16* ob = ri == 0 ? OB : (ri == 1 ? BR1 : BR2);
                            dilated_wave(BIG, b, head, r, c, l0, ob, ri == 0 ? D : 1024, LSE + (size_t)ri * M * 8, btab, lds + 65536 + wave * 8448, w);
                        }
                    }
                    for (int wt = bx * NWAVES + wave; wt < 2048; wt += G * NWAVES) kmean_wave((const bf16*)(ws + WS_KT), (float*)(ws + WS_KMH), wt, lane);
                }
                GRID_BAR();
                {
                    unsigned char* ws = opaque(args.ws); const int G = gridDim.x, bx = blockIdx.x;
                    const int tid = opaque_v(TIDX), lane = tid & 63, wave = __builtin_amdgcn_readfirstlane(tid >> 6);
                    const bf16* BIG = (const bf16*)(ws + WS_BIG); bf16* OB = (bf16*)(ws + WS_O); bf16* BR1 = (bf16*)opaque(args.out); bf16* BR2 = BR1 + (size_t)M * 1024;
                    const float* BIAS = (const float*)(ws + WS_BIAS);
                    LAS float* btab = (LAS float*)(lds + 65536);
                    WCtx w; wctx_init(w, lds + wave * 8192, lane);
                    int cur_hh = -1;
                    for (int rep = 0; rep < REP_MOBA; ++rep)
                    for (int task = bx; task < 512; task += G) {
                        const int tt = task & 255, b = tt >> 6, hh = (tt >> 3) & 7, xx = tt & 7, own = task < 256 ? xx : 15 - xx;
                        if (hh != cur_hh) {
                            __syncthreads();
                            for (int i = tid; i < 4096; i += NTHR) btab[i] = BIAS[(8 + hh) * 4096 + i];
                            for (int i = tid; i < 1024; i += NTHR) ((LAS unsigned*)(lds + 81920))[i] = ((const unsigned*)(ws + WS_BKT))[i];
                            __syncthreads();
                            cur_hh = hh; }
                        moba_wg(BIG, (const bf16*)(ws + WS_KT), (const float*)(ws + WS_KMH), b, hh, own, wave, tid, OB, btab, (const LAS unsigned char*)(lds + 81920), lds, w);
                    }
                    const int gw = bx * NWAVES + wave, NGW = G * NWAVES;
                    for (int tok = gw; tok < M; tok += NGW) combine_wave(OB, BR1, BR2, (const float*)(ws + WS_LSE), tok, lane);
                }
                GRID_BAR();
            } else {
                {
                    unsigned char* ws = opaque(args.ws); const int G = gridDim.x, bx = blockIdx.x;
                    const int tid = opaque_v(TIDX), lane = tid & 63, wave = __builtin_amdgcn_readfirstlane(tid >> 6);
                    WCtx w; wctx_init(w, lds + wave * 8192, lane);
                    for (int rep = 0; rep < REP_SB; ++rep)
                    for (int task = bx; task < 1024; task += G) {
                        const int b = task >> 8, head = (task >> 4) & 15, qb = task & 15;
                        sb_wave((const bf16*)(ws + WS_BIG), (const bf16*)(ws + WS_KT), b, head, qb * 256 + wave * 32, (bf16*)(ws + WS_O), w);
                    }
                }
                GRID_BAR();
            }
            {
                unsigned char* ws = opaque(args.ws); const int G = gridDim.x, bx = blockIdx.x; float* out = opaque(args.out);
                pg8::Gemm g{(const bf16*)(ws + WS_O), (const bf16*)(ws + WS_WO + layer * SZ_WO), M, D, D}; pg8::StaticOrder S; S.init(M, D, G, cidx);
                pg8::EpiResid E{(bf16*)(ws + WS_U), (float*)(ws + WS_SS) + (size_t)(s + 1) * M * 32, D, 1.0f};
                pg8::gemm_phase<pg8::EpiResid, pg8::StaticOrder, true, true>(lds, g, S, E, wave_s);
            }
            GRID_BAR();
        }
}

__global__ void __launch_bounds__(NTHR, 2) fwd_megakernel(Args args) {
    cg::grid_group grid = cg::this_grid();
    LAS unsigned char* lds = (LAS unsigned char*)pg8::lds_raw;
    volatile LAS unsigned* bst = (volatile LAS unsigned*)(lds + 155648);
    if (threadIdx.x < 2) bst[threadIdx.x] = 0u;
    __syncthreads();
    const XcdBarrier bar = xcd_barrier_post((unsigned*)(args.ws + WS_CTL), bst);
    const int wave_s = bar.wv;
    unsigned* xcnt = (unsigned*)(args.ws + WS_CTL + 15360);
    if (TIDX == 0) bst[4] = __hip_atomic_fetch_add(xcnt + 16 * bar.x, 1u, __ATOMIC_RELAXED, __HIP_MEMORY_SCOPE_AGENT);

#ifndef REP_ALL
#define REP_ALL 1
#endif
    STAMP();
#pragma unroll 1
    for (int rep_all = 0; rep_all < REP_ALL; ++rep_all) {
    if (rep_all > 0) GRID_BAR();
    {
        const int tid = opaque_v(TIDX), lane = tid & 63, wave = __builtin_amdgcn_readfirstlane(tid >> 6);
        const int G = gridDim.x, bx = blockIdx.x, gw = bx * NWAVES + wave, NGW = G * NWAVES;
        for (int rep = 0; rep < REP_P0; ++rep)
        p0_weights(args, gw, NGW, lane);
        p0_bias(args, bx * NTHR + tid, G * NTHR);
        const float* x = as_global(args.in[0]); unsigned char* wsg = as_global(args.ws); bf16* HB = (bf16*)(wsg + WS_U); float* SS = (float*)(wsg + WS_SS);
        for (int mrow = gw; mrow < M; mrow += NGW) x_row(x + (size_t)mrow * D, HB + (size_t)mrow * D, SS + (size_t)mrow * 32, lane);
    }
    if (rep_all == 0) { grid.sync(); STAMP(); } else GRID_BAR();
    if (TIDX == 0) { bool even = (gridDim.x % 8u) == 0u;
        for (int j = 0; j < 8; ++j) even = even && (__hip_atomic_load(xcnt + 16 * j, __ATOMIC_RELAXED, __HIP_MEMORY_SCOPE_AGENT) == gridDim.x / 8u);
        bst[5] = (even && bar.x < 8u) ? (bst[4] * 8u + bar.x) : blockIdx.x; }
    __syncthreads();
    const int cidx = __builtin_amdgcn_readfirstlane((int)bst[5]);

    fwd_step<0>(args, lds, bar, wave_s, cidx); fwd_step<1>(args, lds, bar, wave_s, cidx); fwd_step<2>(args, lds, bar, wave_s, cidx);
    fwd_step<3>(args, lds, bar, wave_s, cidx); fwd_step<4>(args, lds, bar, wave_s, cidx); fwd_step<5>(args, lds, bar, wave_s, cidx);
    {
        unsigned char* ws = opaque(args.ws); float* out = opaque(args.out);
        const int tid = opaque_v(TIDX), lane = tid & 63, wave = __builtin_amdgcn_readfirstlane(tid >> 6);
        const int gw = blockIdx.x * NWAVES + wave, NGW = gridDim.x * NWAVES;
        const float* g = as_global(args.in[10]); const float* SS = (const float*)(ws + WS_SS) + (size_t)6 * M * 32;
        for (int mrow = gw; mrow < M; mrow += NGW) final_row(out + (size_t)mrow * D, (const bf16*)(ws + WS_U) + (size_t)mrow * D, g, SS + (size_t)mrow * 32, lane);
    }
    }
}

extern "C" void kernel_launch(void* const* d_in, const int* in_sizes, int n_in, void* d_out, int out_size, void* d_ws, size_t ws_size, hipStream_t stream) {
    static int grid = 0;
    if (grid == 0) {
        if (n_in != 11 || in_sizes[0] != M * D || out_size != M * D || ws_size < WS_END) {
            fprintf(stderr, "kernel_launch: shape/workspace mismatch (n_in %d, in0 %d, out %d, ws %zu, need %zu); nothing launched\n", n_in, n_in > 0 ? in_sizes[0] : -1, out_size, ws_size, (size_t)WS_END);
            grid = -1; return; }
        int dev = 0, cus = 0, per_cu = 0;
        (void)hipGetDevice(&dev); (void)hipDeviceGetAttribute(&cus, hipDeviceAttributeMultiprocessorCount, dev);
        if (hipFuncSetAttribute((const void*)fwd_megakernel, hipFuncAttributeMaxDynamicSharedMemorySize, LDS_BYTES) != hipSuccess) { fprintf(stderr, "kernel_launch: hipFuncSetAttribute failed\n"); grid = -1; return; }
        if (hipOccupancyMaxActiveBlocksPerMultiprocessor(&per_cu, (const void*)fwd_megakernel, NTHR, LDS_BYTES) != hipSuccess || per_cu < 1) { fprintf(stderr, "kernel_launch: occupancy query gave %d\n", per_cu); per_cu = 1; }
        (void)hipGetLastError();
        grid = cus * 1;
        if (grid > 256) grid = 256;
        if (grid != 256) { fprintf(stderr, "kernel_launch: built for a 256-CU MI355X (the GEMM epilogues rely on the 256-workgroup unit order); device has %d CUs; nothing launched\n", cus); grid = -1; return; }
    }
    if (grid < 0) return;
    if (hipMemsetAsync((char*)d_ws + WS_CTL, 0, CTL_BYTES, stream) != hipSuccess) { fprintf(stderr, "kernel_launch: memset of the barrier words failed\n"); return; }
    Args a{};
    for (int i = 0; i < 11; ++i) a.in[i] = (const float*)d_in[i];
    a.out = (float*)d_out; a.ws = (unsigned char*)d_ws;
    void* kargs[] = {&a};
    hipError_t e = hipLaunchCooperativeKernel((const void*)fwd_megakernel, dim3(grid), dim3(NTHR), kargs, LDS_BYTES, stream);
    if (e != hipSuccess) fprintf(stderr, "kernel_launch: cooperative launch failed: %s (grid %d)\n", hipGetErrorString(e), grid);
}
```

```cpp
#include <hip/hip_runtime.h>
#include <hip/hip_cooperative_groups.h>
#include <cstdio>
#include <cstdint>
namespace cg = cooperative_groups;
namespace pg8 {
#define PG8_LAS __attribute__((address_space(3)))
extern __shared__ __attribute__((aligned(16))) unsigned char lds_raw[];
__device__ __forceinline__ int lane_id() { return (int)__builtin_amdgcn_mbcnt_hi(~0u, __builtin_amdgcn_mbcnt_lo(~0u, 0u)); }
typedef unsigned short bf16_t;
typedef short bf16x8 __attribute__((ext_vector_type(8)));
typedef float f32x4 __attribute__((ext_vector_type(4)));
typedef unsigned u32x4 __attribute__((ext_vector_type(4)));
constexpr int BM = 256, BK = 64, HALF = 128, HTB = HALF * BK * 2  , STAGE_BYTES = 8 * HTB, NXCD = 8, WGM = 8;

__host__ __device__ __forceinline__ int lds_byte(int r, int c) { const int st = (r >> 4) * 2 + (c >> 5), rr = r & 15, cc = c & 31, ob = rr * 64 + cc * 2; return st * 1024 + (ob ^ (((ob >> 9) & 1) << 5)); }
__host__ __device__ __forceinline__ void stage_rc(int b, int& R, int& C) { const int st = b / 1024, sb = b % 1024, swz = sb ^ (((sb >> 9) & 1) << 5); R = (st >> 1) * 16 + swz / 64; C = (st & 1) * 32 + (swz % 64) / 2; }
__host__ __device__ __forceinline__ int perm32(int rho) { const int n = rho >> 4, i = rho & 15; return 8 * (i >> 2) + 4 * n + (i & 3); }

struct Unit { int pm, pn; };
struct Gemm { const bf16_t* A; const bf16_t* Bt; int M, N, K; };

struct StaticOrder {
    int nM, nN, nwg, G, c;
    __host__ __device__ void init(int M, int N, int G_, int c_) { nM = M / BM; nN = N / BM; nwg = nM * nN; G = G_; c = c_; }
    __host__ __device__ bool next(int i, Unit& u) const {
        const long L = (long)i * G + c; if (L >= nwg) return false;
        int wgid = (int)L; { const int q = nwg / NXCD, r = nwg % NXCD, xcd = wgid % NXCD, off = wgid / NXCD; wgid = (xcd < r ? xcd * (q + 1) : r * (q + 1) + (xcd - r) * q) + off; }
        const int nig = WGM * nN, gid = wgid / nig, fm = gid * WGM, gsz = (nM - fm) < WGM ? (nM - fm) : WGM;
        u.pm = fm + ((wgid % nig) % gsz); u.pn = (wgid % nig) / gsz; return true;
    }
    __device__ __forceinline__ void a_ready(const Unit&) const {}
    __device__ __forceinline__ void done(const Unit&) const {}
};

__device__ __forceinline__ unsigned cvt_pk_bf16(float lo, float hi) { unsigned r; asm volatile("v_cvt_pk_bf16_f32 %0, %1, %2" : "=v"(r) : "v"(lo), "v"(hi)); return r; }
typedef float f32x2 __attribute__((ext_vector_type(2)));
__device__ __forceinline__ f32x2 gelu_pk(f32x2 v) {
    const f32x2 av = __builtin_elementwise_abs(v), d = av * 0.2316418882f + 1.0f;
    f32x2 t; t.x = __builtin_amdgcn_rcpf(d.x); t.y = __builtin_amdgcn_rcpf(d.y);
    f32x2 q = t * 0.5307027145f + (-0.7265760135f); q = q * t + 0.7107068705f; q = q * t + (-0.142248368f); q = q * t + 0.127414796f; q = q * t;
    const f32x2 s = (v * v) * (-0.72134752044f);
    f32x2 e; e.x = __builtin_amdgcn_exp2f(s.x); e.y = __builtin_amdgcn_exp2f(s.y);
    const f32x2 m = v * (q * e), r = v - m;
    f32x2 o; o.x = v.x < 0.f ? m.x : r.x; o.y = v.y < 0.f ? m.y : r.y; return o;
}

template <int ACT  > struct EpiBf16 {
    static constexpr bool PERM = true, AFTER_DRAIN = false; static_assert(ACT == 0 || ACT == 1, "EpiBf16: ACT is 0 (none) or 1 (gelu_pk)");
    bf16_t* O; int ldc; const float* bias; int split_cols; size_t split_stride; float scale0;
    __device__ __forceinline__ void operator()(const f32x4 (&acc)[2][2][4][2], const Unit& u, int wr, int wc, int fr, int fq) const {
        const int row0 = u.pm * BM + wr * 64 + fr; int colt = u.pn * BM; bf16_t* base = O;
        float sc = 1.f; if (split_cols) { const int t = colt / split_cols; base += (size_t)t * split_stride; colt -= t * split_cols; if (t == 0) sc = scale0; }
        const int col0 = colt + wc * 32 + 8 * fq, bcol0 = u.pn * BM + wc * 32 + 8 * fq;
        f32x4 bv[2][2];
#pragma unroll
        for (int bj = 0; bj < 2; ++bj)
#pragma unroll
            for (int n = 0; n < 2; ++n) bv[bj][n] = bias ? *(const f32x4*)(bias + bcol0 + bj * HALF + 4 * n) : (f32x4){0.f, 0.f, 0.f, 0.f};
#pragma unroll
        for (int ai = 0; ai < 2; ++ai)
#pragma unroll
            for (int m = 0; m < 4; ++m) { bf16_t* rowp = base + (size_t)(row0 + ai * HALF + m * 16) * ldc + col0;
#pragma unroll
                for (int bj = 0; bj < 2; ++bj) { f32x4 v0 = acc[ai][bj][m][0] + bv[bj][0], v1 = acc[ai][bj][m][1] + bv[bj][1];
                    if (ACT == 1) { f32x2 a = gelu_pk((f32x2){v0[0], v0[1]}), b = gelu_pk((f32x2){v0[2], v0[3]}), c = gelu_pk((f32x2){v1[0], v1[1]}), d = gelu_pk((f32x2){v1[2], v1[3]});
                        v0 = (f32x4){a.x, a.y, b.x, b.y}; v1 = (f32x4){c.x, c.y, d.x, d.y}; }
                    v0 = v0 * sc; v1 = v1 * sc; u32x4 w; w.x = cvt_pk_bf16(v0[0], v0[1]); w.y = cvt_pk_bf16(v0[2], v0[3]); w.z = cvt_pk_bf16(v1[0], v1[1]); w.w = cvt_pk_bf16(v1[2], v1[3]);
                    *(u32x4*)(rowp + bj * HALF) = w; } }
    }
};
__device__ __forceinline__ void load_rstd8_lds(const PG8_LAS float* rt, int rloc, float (&rs)[2][4]) {
#pragma unroll
    for (int ai = 0; ai < 2; ++ai)
#pragma unroll
        for (int m = 0; m < 4; ++m) rs[ai][m] = rt[rloc + ai * HALF + m * 16];
}
__device__ __forceinline__ void load_rstd8(const float* ss, int row0, float (&rs)[2][4]) {
    float v[2][4];
#pragma unroll
    for (int ai = 0; ai < 2; ++ai)
#pragma unroll
        for (int m = 0; m < 4; ++m) v[ai][m] = ss[row0 + ai * HALF + m * 16];
#pragma unroll
    for (int ai = 0; ai < 2; ++ai)
#pragma unroll
        for (int m = 0; m < 4; ++m) rs[ai][m] = __builtin_amdgcn_rsqf(v[ai][m] * (1.0f / 2048.0f) + 1e-6f);
}
struct EpiSwiglu {
    static constexpr bool PERM = true, AFTER_DRAIN = false;
    bf16_t* O; int ldc; const float* ss; int pm0;
    __device__ __forceinline__ void operator()(const f32x4 (&acc)[2][2][4][2], const Unit& u, int wr, int wc, int fr, int fq) const {
        const int row0 = u.pm * BM + wr * 64 + fr, col0 = (43 - u.pn) * HALF + wc * 32 + 8 * fq;
        float rsv[2][4]; load_rstd8_lds((const PG8_LAS float*)((PG8_LAS unsigned char*)lds_raw + 155712), wr * 64 + fr, rsv);
#pragma unroll
        for (int ai = 0; ai < 2; ++ai)
#pragma unroll
            for (int m = 0; m < 4; ++m) {
                const int row = row0 + ai * HALF + m * 16; bf16_t* rowp = O + (size_t)row * ldc + col0;
                const float rs = rsv[ai][m];
                float r[8];
#pragma unroll
                for (int n = 0; n < 2; ++n)
#pragma unroll
                    for (int e = 0; e < 4; ++e) { const float g = acc[ai][0][m][n][e] * rs, up = acc[ai][1][m][n][e] * rs;
                        const float sg = g * __builtin_amdgcn_rcpf(1.0f + __builtin_amdgcn_exp2f(-1.44269504089f * g)); r[4 * n + e] = sg * up; }
                u32x4 w; w.x = cvt_pk_bf16(r[0], r[1]); w.y = cvt_pk_bf16(r[2], r[3]); w.z = cvt_pk_bf16(r[4], r[5]); w.w = cvt_pk_bf16(r[6], r[7]);
                *(u32x4*)rowp = w; }
    }
};
struct EpiResid {
    static constexpr bool PERM = true, AFTER_DRAIN = false;
    bf16_t* hi; float* ss; int ldc; float scale;
    __device__ __forceinline__ void operator()(const f32x4 (&acc)[2][2][4][2], const Unit& u, int wr, int wc, int fr, int fq) const {
        const int row0 = u.pm * BM + wr * 64 + fr, col0 = u.pn * BM + wc * 32 + 8 * fq;
#pragma unroll
        for (int ai = 0; ai < 2; ++ai)
#pragma unroll
            for (int m = 0; m < 4; ++m) { const int row = row0 + ai * HALF + m * 16; const size_t off = (size_t)row * ldc + col0; float q = 0.f;
#pragma unroll
                for (int bj = 0; bj < 2; ++bj) { const size_t ix = off + bj * HALF;
                    const u32x4 xh = *(const u32x4*)(hi + ix);
                    u32x4 wh;
#pragma unroll
                    for (int e = 0; e < 4; ++e) {
                        const float a = acc[ai][bj][m][e >> 1][2 * (e & 1)], b = acc[ai][bj][m][e >> 1][2 * (e & 1) + 1];
                        const float o0 = __uint_as_float(xh[e] << 16) + a * scale, o1 = __uint_as_float(xh[e] & 0xffff0000u) + b * scale;
                        const unsigned h2 = cvt_pk_bf16(o0, o1); wh[e] = h2;
                        const float r0 = __uint_as_float(h2 << 16), r1 = __uint_as_float(h2 & 0xffff0000u);
                        q += r0 * r0 + r1 * r1; }
                    *(u32x4*)(hi + ix) = wh; }
                q += __shfl_xor(q, 16); q += __shfl_xor(q, 32);
                if (fq == 0) ss[(size_t)row * 32 + u.pn * 4 + wc] = q;
                }
    }
};
struct EpiQkv {
    static constexpr bool PERM = true, AFTER_DRAIN = false;
    bf16_t* O; int ldc; const float* ss; int pm0; bf16_t* KT; int kt_lo;
    __device__ __forceinline__ void operator()(const f32x4 (&acc)[2][2][4][2], const Unit& u, int wr, int wc, int fr, int fq) const {
        const int row0 = u.pm * BM + wr * 64 + fr, col0 = u.pn * BM + wc * 32 + 8 * fq;
        float rsv[2][4]; load_rstd8_lds((const PG8_LAS float*)((PG8_LAS unsigned char*)lds_raw + 155712), wr * 64 + fr, rsv);
        if (u.pn >= kt_lo && u.pn < 16) {
#pragma unroll
            for (int ai = 0; ai < 2; ++ai)
#pragma unroll
                for (int m = 0; m < 4; ++m) { const int row = row0 + ai * HALF + m * 16;
                    const float rs = rsv[ai][m];
                    const int b = row >> 12, key = row & 4095;
#pragma unroll
                    for (int bj = 0; bj < 2; ++bj) { const int head = (u.pn - 8) * 2 + bj;
                        bf16_t* p = KT + ((size_t)((b * 16 + head) * 128 + (key >> 5)) << 12) + (wc * 2 + (fq >> 1)) * 512 + ((fq & 1) * 32 + (key & 31)) * 8;
                        const f32x4 v0 = acc[ai][bj][m][0] * rs, v1 = acc[ai][bj][m][1] * rs;
                        u32x4 w; w.x = cvt_pk_bf16(v0[0], v0[1]); w.y = cvt_pk_bf16(v0[2], v0[3]); w.z = cvt_pk_bf16(v1[0], v1[1]); w.w = cvt_pk_bf16(v1[2], v1[3]);
                        *(u32x4*)p = w; } }
            return; }
#pragma unroll
        for (int ai = 0; ai < 2; ++ai)
#pragma unroll
            for (int m = 0; m < 4; ++m) { const int row = row0 + ai * HALF + m * 16;
                const float rs = rsv[ai][m];
                bf16_t* rowp = O + (size_t)row * ldc + col0;
#pragma unroll
                for (int bj = 0; bj < 2; ++bj) { const f32x4 v0 = acc[ai][bj][m][0] * rs, v1 = acc[ai][bj][m][1] * rs;
                    u32x4 w; w.x = cvt_pk_bf16(v0[0], v0[1]); w.y = cvt_pk_bf16(v0[2], v0[3]); w.z = cvt_pk_bf16(v1[0], v1[1]); w.w = cvt_pk_bf16(v1[2], v1[3]);
                    *(u32x4*)(rowp + bj * HALF) = w; } }
    }
};
template <class Epi, class Sched, bool ALIGN_EPI = false, bool SP2 = false>
__device__ __forceinline__ void gemm_phase(PG8_LAS unsigned char* lds, const Gemm g, const Sched& S, const Epi& E, int wave_s  ) {
    int tid_ = wave_s * 64 + lane_id(); asm volatile("" : "+v"(tid_));
    const int tid = tid_, wid = __builtin_amdgcn_readfirstlane(tid >> 6), lane = tid & 63, wr = wid >> 2, wc = wid & 3, fr = lane & 15, fq = lane >> 4;
    const int K = g.K, nt = K / BK;
    unsigned voffA[2], voffB[2];
#pragma unroll
    for (int i = 0; i < 2; ++i) { int R, C; stage_rc(tid * 16 + i * 8192, R, C); const int Rb = Epi::PERM ? ((R & ~31) + perm32(R & 31)) : R;
        voffA[i] = (unsigned)(R * K + C) * 2u; voffB[i] = (unsigned)(Rb * K + C) * 2u; }
    const size_t kstep = (size_t)(BK * 2);
    const size_t hstep = (size_t)HALF * K * 2;
    const size_t tstep = 2 * hstep;
    const unsigned ldsw = (unsigned)wid * 1024u;
    const int aoff = lds_byte(wr * 64 + fr, fq * 8), boff = lds_byte(wc * 32 + fr, fq * 8);
#define PG8_SA(b, h) (((b) * 2 + (h)) * HTB)
#define PG8_SB(b, h) ((4 + (b) * 2 + (h)) * HTB)
#define PG8_STAGE(bufoff, gbase, voff) do { _Pragma("unroll") for (int _i = 0; _i < 2; ++_i) \
        __builtin_amdgcn_global_load_lds((const unsigned*)((const char*)(gbase) + (voff)[_i]), (PG8_LAS unsigned*)(lds + (bufoff) + ldsw + _i * 8192), 16, 0, 0); } while (0)
#define PG8_LDA(dst, b, h) do { _Pragma("unroll") for (int m = 0; m < 4; ++m) _Pragma("unroll") for (int k = 0; k < 2; ++k) dst[m][k] = *(const PG8_LAS bf16x8*)(lds + PG8_SA(b, h) + aoff + m * 2048 + k * 1024); } while (0)
#define PG8_LDB(dst, b, h) do { _Pragma("unroll") for (int n = 0; n < 2; ++n) _Pragma("unroll") for (int k = 0; k < 2; ++k) dst[n][k] = *(const PG8_LAS bf16x8*)(lds + PG8_SB(b, h) + boff + n * 2048 + k * 1024); } while (0)
#define PG8_MMA(ai, bj, At, Bt) do { __builtin_amdgcn_s_setprio(1); _Pragma("unroll") for (int m = 0; m < 4; ++m) _Pragma("unroll") for (int n = 0; n < 2; ++n) _Pragma("unroll") for (int k = 0; k < 2; ++k) \
        acc[ai][bj][m][n] = __builtin_amdgcn_mfma_f32_16x16x32_bf16(Bt[n][k], At[m][k], acc[ai][bj][m][n], 0, 0, 0); __builtin_amdgcn_s_setprio(0); } while (0)
#define PG8_WAIT_V(n) asm volatile("s_waitcnt vmcnt(" #n ")" ::: "memory")
#define PG8_WAIT_L(n) asm volatile("s_waitcnt lgkmcnt(" #n ")" ::: "memory")
#define PG8_BAR __builtin_amdgcn_s_barrier()
#define PG8_SCHED __builtin_amdgcn_sched_barrier(0)
    Unit cur, nxt; int ui = 0;
    if (!S.next(0, cur)) return;
    f32x4 acc[2][2][4][2];
#pragma unroll
    for (int a = 0; a < 2; ++a)
#pragma unroll
        for (int b = 0; b < 2; ++b)
#pragma unroll
            for (int m = 0; m < 4; ++m)
#pragma unroll
                for (int n = 0; n < 2; ++n) acc[a][b][m][n] = (f32x4){0.f, 0.f, 0.f, 0.f};
    bf16x8 At[4][2], B0[2][2], B1[2][2];
    const char* cA = (const char*)g.A + (size_t)cur.pm * tstep; const char* cB = (const char*)g.Bt + (size_t)cur.pn * tstep;
    S.a_ready(cur);
    if constexpr (SP2) {
        PG8_STAGE(PG8_SB(0, 0), cB, voffB); PG8_STAGE(PG8_SB(0, 1), cB + hstep, voffB); PG8_STAGE(PG8_SA(0, 0), cA, voffA); PG8_STAGE(PG8_SA(0, 1), cA + hstep, voffA);
        if (wr == 1) PG8_BAR;
        PG8_WAIT_V(2); PG8_BAR;
        PG8_STAGE(PG8_SB(1, 0), cB + kstep, voffB); PG8_STAGE(PG8_SA(1, 0), cA + kstep, voffA); PG8_STAGE(PG8_SB(1, 1), cB + hstep + kstep, voffB);
        PG8_WAIT_V(6); PG8_BAR;
    } else {
        PG8_STAGE(PG8_SB(0, 0), cB, voffB); PG8_STAGE(PG8_SA(0, 0), cA, voffA); PG8_STAGE(PG8_SB(0, 1), cB + hstep, voffB); PG8_STAGE(PG8_SA(0, 1), cA + hstep, voffA);
        if (wr == 1) PG8_BAR;
        PG8_WAIT_V(4); PG8_BAR;
        PG8_STAGE(PG8_SB(1, 0), cB + kstep, voffB); PG8_STAGE(PG8_SA(1, 0), cA + kstep, voffA); PG8_STAGE(PG8_SB(1, 1), cB + hstep + kstep, voffB);
        PG8_WAIT_V(6); PG8_BAR;
    }
    for (;;) {
        const bool has_next = S.next(ui + 1, nxt);
        const char* nA = has_next ? (const char*)g.A + (size_t)nxt.pm * tstep : cA; const char* nB = has_next ? (const char*)g.Bt + (size_t)nxt.pn * tstep : cB;
        for (int t = 0; t < nt; t += 2) {
            const bool last = (t == nt - 2);
            const char* a1 = cA + (size_t)(t + 1) * kstep;
            const char* a2 = last ? nA : cA + (size_t)(t + 2) * kstep; const char* b2 = last ? nB : cB + (size_t)(t + 2) * kstep;
            const char* a3 = a2 + kstep; const char* b3 = b2 + kstep;
            if (last && has_next) S.a_ready(nxt);
            if constexpr (SP2) {
            PG8_LDB(B0, 0, 0); PG8_LDB(B1, 0, 1); PG8_SCHED; PG8_LDA(At, 0, 0); PG8_STAGE(PG8_SA(1, 1), a1 + hstep, voffA);
            PG8_WAIT_V(8); PG8_WAIT_L(0); PG8_BAR; PG8_MMA(0, 0, At, B0); PG8_MMA(0, 1, At, B1); PG8_BAR; PG8_SCHED;
            PG8_LDA(At, 0, 1); PG8_STAGE(PG8_SB(0, 0), b2, voffB); PG8_STAGE(PG8_SB(0, 1), b2 + hstep, voffB); PG8_STAGE(PG8_SA(0, 0), a2, voffA);
            PG8_WAIT_V(8); PG8_WAIT_L(0); PG8_BAR; PG8_MMA(1, 0, At, B0); PG8_MMA(1, 1, At, B1); PG8_BAR; PG8_SCHED;
            PG8_LDB(B0, 1, 0); PG8_LDB(B1, 1, 1); PG8_SCHED; PG8_LDA(At, 1, 0); PG8_STAGE(PG8_SA(0, 1), a2 + hstep, voffA);
            PG8_WAIT_V(8); PG8_WAIT_L(0); PG8_BAR; PG8_MMA(0, 0, At, B0); PG8_MMA(0, 1, At, B1); PG8_BAR; PG8_SCHED;
            PG8_LDA(At, 1, 1); PG8_STAGE(PG8_SB(1, 0), b3, voffB); PG8_STAGE(PG8_SB(1, 1), b3 + hstep, voffB); PG8_STAGE(PG8_SA(1, 0), a3, voffA);
            PG8_WAIT_V(8); PG8_WAIT_L(0); PG8_BAR; PG8_MMA(1, 0, At, B0); PG8_MMA(1, 1, At, B1); PG8_BAR; PG8_SCHED;
            } else {
            PG8_LDB(B0, 0, 0); PG8_SCHED; PG8_LDA(At, 0, 0); PG8_STAGE(PG8_SA(1, 1), a1 + hstep, voffA);
            PG8_WAIT_L(8); PG8_BAR; PG8_WAIT_L(0); PG8_MMA(0, 0, At, B0); PG8_BAR; PG8_SCHED;
            PG8_LDB(B1, 0, 1); PG8_STAGE(PG8_SB(0, 0), b2, voffB);
            PG8_BAR; PG8_WAIT_L(0); PG8_MMA(0, 1, At, B1); PG8_BAR;
            PG8_LDA(At, 0, 1); PG8_STAGE(PG8_SA(0, 0), a2, voffA);
            PG8_BAR; PG8_WAIT_L(0); PG8_MMA(1, 0, At, B0); PG8_BAR; PG8_SCHED;
            PG8_STAGE(PG8_SB(0, 1), b2 + hstep, voffB);
            PG8_WAIT_V(6); PG8_BAR; PG8_MMA(1, 1, At, B1); PG8_BAR;
            PG8_LDB(B0, 1, 0); PG8_SCHED; PG8_LDA(At, 1, 0); PG8_STAGE(PG8_SA(0, 1), a2 + hstep, voffA);
            PG8_WAIT_L(8); PG8_BAR; PG8_WAIT_L(0); PG8_MMA(0, 0, At, B0); PG8_BAR; PG8_SCHED;
            PG8_LDB(B1, 1, 1); PG8_STAGE(PG8_SB(1, 0), b3, voffB);
            PG8_BAR; PG8_WAIT_L(0); PG8_MMA(0, 1, At, B1); PG8_BAR;
            PG8_LDA(At, 1, 1); PG8_STAGE(PG8_SA(1, 0), a3, voffA);
            PG8_BAR; PG8_WAIT_L(0); PG8_MMA(1, 0, At, B0); PG8_BAR; PG8_SCHED;
            PG8_STAGE(PG8_SB(1, 1), b3 + hstep, voffB);
            PG8_WAIT_V(6); PG8_BAR; PG8_MMA(1, 1, At, B1); PG8_BAR;
            }
        }
        if constexpr (ALIGN_EPI) { if (wr == 0) PG8_BAR; }
        if constexpr (!Epi::AFTER_DRAIN) { E(acc, cur, wr, wc, fr, fq); S.done(cur); }
        if (!has_next) break;
#pragma unroll
        for (int a = 0; a < 2; ++a)
#pragma unroll
            for (int b = 0; b < 2; ++b)
#pragma unroll
                for (int m = 0; m < 4; ++m)
#pragma unroll
                    for (int n = 0; n < 2; ++n) acc[a][b][m][n] = (f32x4){0.f, 0.f, 0.f, 0.f};
        cur = nxt; cA = nA; cB = nB; ++ui;
        if constexpr (ALIGN_EPI) { if (wr == 1) PG8_BAR; }
    }
    PG8_WAIT_V(0);
    if constexpr (!ALIGN_EPI) { if (wr == 0) PG8_BAR; }
    PG8_BAR;
    if constexpr (Epi::AFTER_DRAIN) { E.fused(acc, cur, wr, wc, fr, fq, lds, wid, lane); S.done(cur); }
#undef PG8_SA
#undef PG8_SB
#undef PG8_STAGE
#undef PG8_LDA
#undef PG8_LDB
#undef PG8_MMA
#undef PG8_WAIT_V
#undef PG8_WAIT_L
#undef PG8_BAR
#undef PG8_SCHED
}
}

#define LAS __attribute__((address_space(3)))
typedef unsigned short bf16;
typedef float f32x4 __attribute__((ext_vector_type(4)));
typedef float f32x16 __attribute__((ext_vector_type(16)));
typedef short bf16x8 __attribute__((ext_vector_type(8)));
typedef short s16x4 __attribute__((ext_vector_type(4)));
typedef unsigned u32x2 __attribute__((ext_vector_type(2)));
typedef unsigned u32x4 __attribute__((ext_vector_type(4)));

constexpr int NWAVES = 8, NTHR = 512;
constexpr int BATCH = 4, SEQ = 4096, D = 2048, M = BATCH * SEQ, FF = 5632, NH = 16, HD = 128, NQKV = 3 * D;
constexpr float RMS_EPS = 1e-6f;
constexpr float LOG2E = 1.44269504089f;
constexpr float SC2 = 0.08838834764831845f * LOG2E;

constexpr size_t SZ_W1 = (size_t)2 * FF * D * 2, SZ_W2 = (size_t)D * FF * 2, SZ_WQKV = (size_t)NQKV * D * 2, SZ_WO = (size_t)D * D * 2;
constexpr size_t WS_W1 = 0, WS_W2 = WS_W1 + 4 * SZ_W1, WS_WQKV = WS_W2 + 4 * SZ_W2, WS_WO = WS_WQKV + 2 * SZ_WQKV;
constexpr size_t WS_U = WS_WO + 2 * SZ_WO;
constexpr size_t WS_BIG = WS_U + (size_t)M * D * 2;
constexpr size_t WS_O = WS_BIG + (size_t)M * NQKV * 2;
constexpr size_t WS_LSE = WS_O + (size_t)M * D * 2;
constexpr size_t WS_KMH = WS_LSE + (size_t)3 * M * 8 * 4;
constexpr size_t WS_KML = WS_KMH + (size_t)4 * BATCH * 8 * 16 * 128 * 4;
constexpr size_t WS_BIAS = WS_KML + (size_t)BATCH * 8 * 16 * 128 * 2;
constexpr size_t WS_BKT = WS_BIAS + (size_t)16 * 4096 * 4;
constexpr size_t WS_SS = WS_BKT + 4096;
constexpr size_t WS_KT = WS_SS + (size_t)7 * M * 32 * 4;
constexpr size_t WS_CTL = WS_KT + (size_t)M * D * 2;
constexpr size_t CTL_BYTES = 16384;
constexpr size_t WS_END = WS_CTL + CTL_BYTES;

constexpr int LDS_BYTES = 155648 + 64 + 1024;
#ifndef REP_GEMM
#define REP_GEMM 1
#endif
#ifndef REP_P0
#define REP_P0 1
#endif
#ifndef REP_NORM
#define REP_NORM 1
#endif
#ifndef REP_DIL
#define REP_DIL 1
#endif
#ifndef REP_MOBA
#define REP_MOBA 1
#endif
#ifndef REP_SB
#define REP_SB 1
#endif

struct Args { const float* in[11]; float* out; unsigned char* ws; };

__device__ __forceinline__ float wave_sum(float v) {
#pragma unroll
    for (int o = 1; o < 64; o <<= 1) v += __shfl_xor(v, o);
    return v;
}
__device__ __forceinline__ unsigned cvtpk(float lo, float hi) { return pg8::cvt_pk_bf16(lo, hi); }
template <class T> __device__ __forceinline__ T* as_global(T* p) { return (T*)(__attribute__((address_space(1))) T*)p; }

__device__ __forceinline__ void tr_item(const float* __restrict__ W, int N, bf16* __restrict__ WT, int K, int k0, int n0, int drow0, int lane, const float* __restrict__ gain, int k0dst = -1  ) {
    const int c = lane & 7, n4 = lane >> 3;
    const float* src = W + (size_t)(k0 + 8 * c) * N + n0 + 4 * n4;
    f32x4 v[8];
#pragma unroll
    for (int j = 0; j < 8; ++j) v[j] = __builtin_nontemporal_load((const f32x4*)(src + (size_t)j * N));
    if (gain) {
        const f32x4 g0 = *(const f32x4*)(gain + k0 + 8 * c), g1 = *(const f32x4*)(gain + k0 + 8 * c + 4);
        v[0] *= g0[0]; v[1] *= g0[1]; v[2] *= g0[2]; v[3] *= g0[3]; v[4] *= g1[0]; v[5] *= g1[1]; v[6] *= g1[2]; v[7] *= g1[3]; }
    bf16* dst = WT + (size_t)(drow0 + 4 * n4) * K + (k0dst >= 0 ? k0dst : k0) + 8 * c;
#pragma unroll
    for (int e = 0; e < 4; ++e) {
        u32x4 o; o.x = cvtpk(v[0][e], v[1][e]); o.y = cvtpk(v[2][e], v[3][e]); o.z = cvtpk(v[4][e], v[5][e]); o.w = cvtpk(v[6][e], v[7][e]);
        *(u32x4*)(dst + (size_t)e * K) = o; }
}
__device__ __forceinline__ void p0_weights(const Args& a, int gw, int NGW, int lane) {
    constexpr int I_F = (D / 64) * (FF / 32);
    constexpr int I_Q = (D / 64) * (NQKV / 32);
    constexpr int I_O = (D / 64) * (D / 32);
    constexpr int NITEMS = 12 * I_F + 2 * I_Q + 2 * I_O;
    unsigned char* ws = as_global(a.ws);
    constexpr int B0 = 12 * I_F;
    constexpr int TS[16] = {11 * I_F, 7 * I_F, 3 * I_F, B0 + 2 * I_Q + I_O, B0 + I_Q, 10 * I_F, 6 * I_F, 2 * I_F, 9 * I_F, 5 * I_F, 1 * I_F, B0 + 2 * I_Q, B0, 8 * I_F, 4 * I_F, 0};
    constexpr int TZ[16] = {I_F, I_F, I_F, I_O, I_Q, I_F, I_F, I_F, I_F, I_F, I_F, I_O, I_Q, I_F, I_F, I_F};
    for (int tm = gw; tm < NITEMS; tm += NGW) {
        int it = 0, rr = tm; bool found = false;
#pragma unroll
        for (int j = 0; j < 16; ++j) { if (!found) { if (rr < TZ[j]) { it = TS[j] + rr; found = true; } else rr -= TZ[j]; } }
        if (it < 12 * I_F) {
            const int seg = it / I_F, r = it - seg * I_F, kind = seg >> 2, idx = seg & 3;
            if (kind < 2) {
                const float* W = as_global(a.in[2 + kind]) + (size_t)idx * D * FF;
                const int nnb = FF / 32, kb = r / nnb, nb = r - kb * nnb, n0 = nb * 32;
                tr_item(W, FF, (bf16*)(ws + WS_W1 + idx * SZ_W1), D, kb * 64, n0, (n0 >> 7) * 256 + kind * 128 + (n0 & 127), lane, as_global(a.in[1]) + (size_t)((idx >> 1) * 3 + (idx & 1) * 2) * D);
            } else {
                const float* W = as_global(a.in[4]) + (size_t)idx * FF * D;
                const int nnb = D / 32, kb = r / nnb, nb = r - kb * nnb, n0 = nb * 32;
                tr_item(W, D, (bf16*)(ws + WS_W2 + idx * SZ_W2), FF, kb * 64, n0, n0, lane, nullptr, (43 - ((kb * 64) >> 7)) * 128 + ((kb * 64) & 127));
            }
        } else {
            int r = it - 12 * I_F;
            if (r < 2 * I_Q) { const int l = r / I_Q; r -= l * I_Q; const float* W = as_global(a.in[l == 0 ? 5 : 7]);
                const int nnb = NQKV / 32, kb = r / nnb, nb = r - kb * nnb, n0 = nb * 32;
                tr_item(W, NQKV, (bf16*)(ws + WS_WQKV + l * SZ_WQKV), D, kb * 64, n0, n0, lane, as_global(a.in[1]) + (size_t)(l * 3 + 1) * D);
            } else { r -= 2 * I_Q; const int l = r / I_O; r -= l * I_O; const float* W = as_global(a.in[l == 0 ? 6 : 8]);
                const int nnb = D / 32, kb = r / nnb, nb = r - kb * nnb, n0 = nb * 32;
                tr_item(W, D, (bf16*)(ws + WS_WO + l * SZ_WO), D, kb * 64, n0, n0, lane, nullptr);
            }
        }
    }
}
__device__ __forceinline__ void p0_bias(const Args& a, int gtid, int gthreads) {
    float* bt = (float*)(as_global(a.ws) + WS_BIAS); const float* rb = as_global(a.in[9]);
    for (int i = gtid; i < 16 * 4096; i += gthreads) {
        const int h = i >> 12, d = i & 4095; int bk;
        if (d < 16) bk = d; else { const float df = (float)d; int lg = 16 + (int)(logf(df / 16.0f) / logf(128.0f) * 16.0f); bk = lg < 31 ? lg : 31; }
        bt[i] = rb[bk * 16 + h] * LOG2E;
        if (h == 0) (as_global(a.ws) + WS_BKT)[d] = (unsigned char)bk;
    }
}
template <bool TO_F32>
__device__ __forceinline__ void rms_row(const float* xrow, const float* g, void* orow, int lane) {
    const f32x4* xr = (const f32x4*)xrow + lane; const f32x4* gr = (const f32x4*)g + lane;
    f32x4 v[8]; float s = 0.f;
#pragma unroll
    for (int j = 0; j < 8; ++j) { v[j] = xr[64 * j]; s += (v[j].x * v[j].x + v[j].y * v[j].y) + (v[j].z * v[j].z + v[j].w * v[j].w); }
    const float rstd = 1.0f / sqrtf(wave_sum(s) * (1.0f / D) + RMS_EPS);
#pragma unroll
    for (int j = 0; j < 8; ++j) { const f32x4 gg = gr[64 * j]; const f32x4 y = v[j] * rstd * gg;
        if (TO_F32) ((f32x4*)orow)[lane + 64 * j] = y;
        else { u32x2 w; w.x = cvtpk(y.x, y.y); w.y = cvtpk(y.z, y.w); ((u32x2*)orow)[lane + 64 * j] = w; } }
}

__device__ __forceinline__ void x_row(const float* xrow, bf16* orow, float* ss, int lane) {
    const f32x4* xr = (const f32x4*)xrow + lane; float s = 0.f;
#pragma unroll
    for (int j = 0; j < 8; ++j) { const f32x4 v = xr[64 * j]; u32x2 w; w.x = cvtpk(v.x, v.y); w.y = cvtpk(v.z, v.w); ((u32x2*)orow)[lane + 64 * j] = w;
        const float r0 = __uint_as_float(w.x << 16), r1 = __uint_as_float(w.x & 0xffff0000u), r2 = __uint_as_float(w.y << 16), r3 = __uint_as_float(w.y & 0xffff0000u);
        s += (r0 * r0 + r1 * r1) + (r2 * r2 + r3 * r3); }
    s = wave_sum(s);
    if (lane < 32) ss[lane] = s * (1.0f / 32.0f);
}
__device__ __forceinline__ void final_row(float* orow, const bf16* hrow, const float* g, const float* ss, int lane) {
    const float rstd = 1.0f / sqrtf(wave_sum(lane < 32 ? ss[lane] : 0.f) * (1.0f / D) + RMS_EPS);
    f32x4* xr = (f32x4*)orow + lane; const f32x4* gr = (const f32x4*)g + lane; const u32x2* hr = (const u32x2*)hrow + lane;
#pragma unroll
    for (int j = 0; j < 8; ++j) { const u32x2 a = hr[64 * j]; f32x4 v;
        v.x = __uint_as_float(a.x << 16); v.y = __uint_as_float(a.x & 0xffff0000u); v.z = __uint_as_float(a.y << 16); v.w = __uint_as_float(a.y & 0xffff0000u);
        xr[64 * j] = v * rstd * gr[64 * j]; }
}

#define MFMA32(a, b, c) __builtin_amdgcn_mfma_f32_32x32x16_bf16(a, b, c, 0, 0, 0)
struct WCtx { int lane, q, h; LAS unsigned char* vbuf; unsigned wb[4]; unsigned trb0, trb1; };
__device__ __forceinline__ void wctx_init(WCtx& w, LAS unsigned char* vbuf, int lane) {
    w.lane = lane; w.q = lane & 31; w.h = lane >> 5; w.vbuf = vbuf;
    const int ch = lane & 15, kr = lane >> 4;
#pragma unroll
    for (int x = 0; x < 4; ++x) w.wb[x] = (unsigned)(512 * (ch >> 2) + 64 * kr + 16 * ((ch & 3) ^ x));
    const int qq = (lane & 15) >> 2, p = lane & 3, blk = (lane >> 4) & 1, h = lane >> 5;
    const int x0 = (2 * blk + (p >> 1)) ^ (2 * h);
    w.trb0 = (unsigned)(2048 * h + 64 * qq + 16 * x0 + 8 * (p & 1));
    w.trb1 = (unsigned)(2048 * h + 256 + 64 * qq + 16 * (x0 ^ 1) + 8 * (p & 1));
}
__device__ __forceinline__ void load_q(const bf16* qrow  , bf16x8 (&qf)[8]) {
#pragma unroll
    for (int s = 0; s < 8; ++s) qf[s] = *(const bf16x8*)(qrow + 16 * s);
}
__device__ __forceinline__ f32x16 qk_tile(const bf16* krow  , const bf16x8 (&qf)[8]) {
    bf16x8 kf[8];
#pragma unroll
    for (int s = 0; s < 8; ++s) kf[s] = *(const bf16x8*)(krow + 16 * s);
    f32x16 acc;
#pragma unroll
    for (int i = 0; i < 16; ++i) acc[i] = 0.f;
#pragma unroll
    for (int s = 0; s < 8; ++s) acc = MFMA32(kf[s], qf[s], acc);
    return acc;
}
__device__ __forceinline__ void load_v(const bf16* vt, size_t stride, const WCtx& w, u32x4 (&vr)[8]) {
    const bf16* p = vt + (size_t)(w.lane >> 4) * stride + (w.lane & 15) * 8;
#pragma unroll
    for (int i = 0; i < 8; ++i) vr[i] = *(const u32x4*)(p + (size_t)(4 * i) * stride);
}
__device__ __forceinline__ void stage_v(const WCtx& w, const u32x4 (&vr)[8]) {
#pragma unroll
    for (int i = 0; i < 8; ++i)
        *(LAS u32x4*)(w.vbuf + (2048 * ((i & 1) + 2 * (i >> 2)) + 256 * ((i >> 1) & 1)) + w.wb[((i >> 1) & 1) + 2 * (i & 1)]) = vr[i];
}
__device__ __forceinline__ void pv_tile(const WCtx& w, const bf16x8 (&pf)[2], f32x16 (&o)[4]) {
#pragma unroll
    for (int ks = 0; ks < 2; ++ks)
#pragma unroll
        for (int c = 0; c < 4; ++c) {
            const s16x4 lo = __builtin_amdgcn_ds_read_tr16_b64_v4i16((LAS s16x4*)(w.vbuf + w.trb0 + 4096 * ks + 512 * c));
            const s16x4 hi = __builtin_amdgcn_ds_read_tr16_b64_v4i16((LAS s16x4*)(w.vbuf + w.trb1 + 4096 * ks + 512 * c));
            bf16x8 a; a[0] = lo[0]; a[1] = lo[1]; a[2] = lo[2]; a[3] = lo[3]; a[4] = hi[0]; a[5] = hi[1]; a[6] = hi[2]; a[7] = hi[3];
            o[c] = MFMA32(a, pf[ks], o[c]);
        }
}
__device__ __forceinline__ void pv_tile_b(const LAS unsigned char* vimg, const WCtx& w, const bf16x8 (&pf)[2], f32x16 (&o)[4]) {
#pragma unroll
    for (int ks = 0; ks < 2; ++ks)
#pragma unroll
        for (int c = 0; c < 4; ++c) {
            const s16x4 lo = __builtin_amdgcn_ds_read_tr16_b64_v4i16((LAS s16x4*)(vimg + w.trb0 + 4096 * ks + 512 * c));
            const s16x4 hi = __builtin_amdgcn_ds_read_tr16_b64_v4i16((LAS s16x4*)(vimg + w.trb1 + 4096 * ks + 512 * c));
            bf16x8 a; a[0] = lo[0]; a[1] = lo[1]; a[2] = lo[2]; a[3] = lo[3]; a[4] = hi[0]; a[5] = hi[1]; a[6] = hi[2]; a[7] = hi[3];
            o[c] = MFMA32(a, pf[ks], o[c]);
        }
}
__device__ __forceinline__ void pack_p(const float (&p)[16], bf16x8 (&pf)[2]) {
#pragma unroll
    for (int ks = 0; ks < 2; ++ks) {
        u32x4 w; w.x = cvtpk(p[8 * ks + 0], p[8 * ks + 1]); w.y = cvtpk(p[8 * ks + 2], p[8 * ks + 3]); w.z = cvtpk(p[8 * ks + 4], p[8 * ks + 5]); w.w = cvtpk(p[8 * ks + 6], p[8 * ks + 7]);
        pf[ks] = __builtin_bit_cast(bf16x8, w); }
}
__device__ __forceinline__ float xh_max(float v) { const auto r = __builtin_amdgcn_permlane32_swap(__float_as_uint(v), __float_as_uint(v), false, false); return fmaxf(__uint_as_float(r[0]), __uint_as_float(r[1])); }
__device__ __forceinline__ float xh_sum(float v) { const auto r = __builtin_amdgcn_permlane32_swap(__float_as_uint(v), __float_as_uint(v), false, false); return __uint_as_float(r[0]) + __uint_as_float(r[1]); }
__device__ __forceinline__ float xh_other(float v, int h) { const auto r = __builtin_amdgcn_permlane32_swap(__float_as_uint(v), __float_as_uint(v), false, false); return __uint_as_float(h == 0 ? r[1] : r[0]); }
__device__ __forceinline__ void softmax_step(const float (&s)[16], float& m, float& l, f32x16 (&o)[4], bf16x8 (&pf)[2]) {
    float mx = s[0];
#pragma unroll
    for (int i = 1; i < 16; ++i) mx = fmaxf(mx, s[i]);
    mx = xh_max(mx);
    const float mn = fmaxf(m, mx), mu = (mn == -INFINITY) ? 0.f : mn;
    const float alpha = __builtin_amdgcn_exp2f(m - mu);
    float p[16], ps = 0.f;
#pragma unroll
    for (int i = 0; i < 16; ++i) { p[i] = __builtin_amdgcn_exp2f(s[i] - mu); ps += p[i]; }
    l = l * alpha + ps; m = mn;
    if (__builtin_amdgcn_ballot_w64(alpha != 1.0f) != 0ull) {
#pragma unroll
        for (int c = 0; c < 4; ++c)
#pragma unroll
            for (int i = 0; i < 16; ++i) o[c][i] *= alpha; }
    pack_p(p, pf);
}
__device__ __forceinline__ void write_o(const f32x16 (&o)[4], float mul, bf16* orow, int h) {
#pragma unroll
    for (int c = 0; c < 4; ++c)
#pragma unroll
        for (int g = 0; g < 4; ++g) { u32x2 w; w.x = cvtpk(o[c][4 * g] * mul, o[c][4 * g + 1] * mul); w.y = cvtpk(o[c][4 * g + 2] * mul, o[c][4 * g + 3] * mul);
            *(u32x2*)(orow + 32 * c + 8 * g + 4 * h) = w; }
}
#define ZERO_O(o) do { _Pragma("unroll") for (int c_ = 0; c_ < 4; ++c_) _Pragma("unroll") for (int i_ = 0; i_ < 16; ++i_) o[c_][i_] = 0.f; } while (0)

__device__ __forceinline__ void load_k(const bf16* krow  , bf16x8 (&kf)[8]) {
#pragma unroll
    for (int s = 0; s < 8; ++s) kf[s] = *(const bf16x8*)(krow + 16 * s);
}
__device__ __forceinline__ void load_kt(const bf16* kt  , bf16x8 (&kf)[8]) {
#pragma unroll
    for (int s = 0; s < 8; ++s) kf[s] = *(const bf16x8*)(kt + 512 * s);
}
__device__ __forceinline__ f32x16 qk_mma(const bf16x8 (&kf)[8], const bf16x8 (&qf)[8]) {
    f32x16 acc;
#pragma unroll
    for (int i = 0; i < 16; ++i) acc[i] = 0.f;
#pragma unroll
    for (int s = 0; s < 8; ++s) acc = MFMA32(kf[s], qf[s], acc);
    return acc;
}
__device__ __forceinline__ void load_vp(const bf16* p  , size_t stride, u32x4 (&vr)[8]) {
#pragma unroll
    for (int i = 0; i < 8; ++i) vr[i] = *(const u32x4*)(p + (size_t)(4 * i) * stride);
}

__device__ __forceinline__ void stage_k(LAS unsigned char* kimg, int lane, const u32x4 (&kr)[8]) {
    LAS unsigned char* p = kimg + ((unsigned)lane & 15u) * 528u + ((unsigned)lane >> 4) * 16u;
#pragma unroll
    for (int i = 0; i < 8; ++i) *(LAS u32x4*)(p + 64 * i) = kr[i];
}
__device__ __forceinline__ f32x16 qk_mma_img(const LAS unsigned char* kimg, int lane, const bf16x8 (&qf)[8]) {
    const LAS unsigned char* p = kimg + ((unsigned)lane >> 5) * 528u + ((unsigned)lane & 31u) * 16u;
    bf16x8 kf[8];
#pragma unroll
    for (int s = 0; s < 8; ++s) kf[s] = *(const LAS bf16x8*)(p + 1056 * s);
    return qk_mma(kf, qf);
}

#define PIN16(a) asm volatile("" : "+v"(a[0]), "+v"(a[1]), "+v"(a[2]), "+v"(a[3]), "+v"(a[4]), "+v"(a[5]), "+v"(a[6]), "+v"(a[7]), "+v"(a[8]), "+v"(a[9]), "+v"(a[10]), "+v"(a[11]), "+v"(a[12]), "+v"(a[13]), "+v"(a[14]), "+v"(a[15]))
__device__ __forceinline__ void dilated_wave(const bf16* qkv, int b, int head, int r, int c, int l0, bf16* obase, int o_ld, float* lse_out, const LAS float* btab, LAS unsigned char* kimg  , const WCtx& w) {
    const size_t tokq = (size_t)b * SEQ + (size_t)(l0 + w.q) * r + c;
    bf16x8 qf[8]; load_q(qkv + tokq * NQKV + head * HD + 8 * w.h, qf);
    f32x16 o[4]; ZERO_O(o); float m = -INFINITY, l = 0.f;
    const size_t vstride = (size_t)r * NQKV, tstep = 32 * vstride;
    int j = l0 >= 128 ? 0 : (128 - l0) >> 5;
    const size_t tok0 = (size_t)b * SEQ + (size_t)(l0 - 128 + 32 * j) * r + c;
    const bf16* vp = qkv + (tok0 + (size_t)(w.lane >> 4) * r) * NQKV + 2 * D + head * HD + (w.lane & 15) * 8;
    const bf16* kp = vp - D;
    u32x4 kr[8]; u32x4 vr[8]; load_vp(kp, vstride, kr); load_vp(vp, vstride, vr);
#pragma unroll 1
    for (;;) {
        stage_k(kimg, w.lane, kr);
        const f32x16 acc = qk_mma_img(kimg, w.lane, qf);
        const bool more = j < 4;
        if (more) { kp += tstep; load_vp(kp, vstride, kr); }
        float s[16], bv[16];
#pragma unroll
        for (int i = 0; i < 16; ++i) { const int kk = 8 * (i >> 2) + 4 * w.h + (i & 3); const int rel = 128 - 32 * j + w.q - kk;
            bv[i] = btab[min(max(rel, 0), 128) * r]; }
        PIN16(bv);
#pragma unroll
        for (int i = 0; i < 16; ++i) { const int kk = 8 * (i >> 2) + 4 * w.h + (i & 3);
            const bool valid = ((j != 0) | (kk >= w.q)) & ((j != 4) | (kk <= w.q));
            s[i] = fminf(acc[i] * SC2 + bv[i], valid ? INFINITY : -INFINITY); }
        bf16x8 pf[2]; softmax_step(s, m, l, o, pf);
        stage_v(w, vr);
        pv_tile(w, pf, o);
        if (!more) break;
        vp += tstep; load_vp(vp, vstride, vr);
        ++j;
    }
    const float lt = xh_sum(l), inv = 1.0f / lt;
    write_o(o, inv, obase + tokq * o_ld + head * HD, w.h);
    if (w.h == 0) lse_out[tokq * 8 + head] = m + __builtin_amdgcn_logf(lt);
}

__device__ __forceinline__ void moba_wave(const bf16* qkv, const bf16* KT, const float* kmq, int b, int hh, int t0, bf16* O, const LAS float* btab, const LAS unsigned char* bkt, const WCtx& w) {
    const int head = 8 + hh, own = t0 >> 8;
    const size_t tokq = (size_t)b * SEQ + t0 + w.q;
    bf16x8 qf[8]; load_q(qkv + tokq * NQKV + head * HD + 8 * w.h, qf);
    unsigned sel = (1u << own) - 1u;
    if (own > 3) {
        const int n = w.q & 15; const size_t ko = ((size_t)(b * 8 + hh) * 16 + n) * HD + 8 * w.h; constexpr size_t QS = (size_t)BATCH * 8 * 16 * HD;
        f32x16 g;
#pragma unroll
        for (int i = 0; i < 16; ++i) g[i] = 0.f;
#pragma unroll
        for (int s = 0; s < 8; ++s) {
            f32x4 a0 = *(const f32x4*)(kmq + ko + 16 * s), a1 = *(const f32x4*)(kmq + ko + 16 * s + 4);
#pragma unroll
            for (int qd = 1; qd < 4; ++qd) { a0 += *(const f32x4*)(kmq + qd * QS + ko + 16 * s); a1 += *(const f32x4*)(kmq + qd * QS + ko + 16 * s + 4); }
            a0 *= (1.0f / 256.0f); a1 *= (1.0f / 256.0f);
            u32x4 hi; hi.x = cvtpk(a0[0], a0[1]); hi.y = cvtpk(a0[2], a0[3]); hi.z = cvtpk(a1[0], a1[1]); hi.w = cvtpk(a1[2], a1[3]);
            u32x4 lo; lo.x = cvtpk(a0[0] - __uint_as_float(hi.x << 16), a0[1] - __uint_as_float(hi.x & 0xffff0000u)); lo.y = cvtpk(a0[2] - __uint_as_float(hi.y << 16), a0[3] - __uint_as_float(hi.y & 0xffff0000u));
            lo.z = cvtpk(a1[0] - __uint_as_float(hi.z << 16), a1[1] - __uint_as_float(hi.z & 0xffff0000u)); lo.w = cvtpk(a1[2] - __uint_as_float(hi.w << 16), a1[3] - __uint_as_float(hi.w & 0xffff0000u));
            g = MFMA32(__builtin_bit_cast(bf16x8, hi), qf[s], g); g = MFMA32(__builtin_bit_cast(bf16x8, lo), qf[s], g); }
        float pg[8], gv[16];
#pragma unroll
        for (int i = 0; i < 8; ++i) pg[i] = xh_other(g[i], w.h);
#pragma unroll
        for (int nn = 0; nn < 16; ++nn) { const int a = nn >> 3, bb = (nn >> 2) & 1, e = nn & 3; const float v = (bb == w.h) ? g[4 * a + e] : pg[4 * a + e]; gv[nn] = (nn < own) ? v : -INFINITY; }
        sel = 0u;
#pragma unroll
        for (int rd = 0; rd < 3; ++rd) { float best = -INFINITY; int bi = 0;
#pragma unroll
            for (int nn = 0; nn < 16; ++nn) { const bool take = !((sel >> nn) & 1u) && (gv[nn] > best); best = take ? gv[nn] : best; bi = take ? nn : bi; }
            sel |= 1u << bi; }
    }
    unsigned bm = 1u << own;
#pragma unroll
    for (int n = 0; n < 15; ++n) if (__builtin_amdgcn_ballot_w64((sel >> n) & 1u) != 0ull) bm |= 1u << n;
    const int jd = (t0 & 255) >> 5;
    f32x16 o[4]; ZERO_O(o); float m = -INFINITY, l = 0.f;
    const bf16* kb = KT + ((size_t)((b * 16 + head) * 128) << 12) + w.lane * 8;
    const bf16* vb = qkv + ((size_t)b * SEQ + (w.lane >> 4)) * NQKV + 2 * D + head * HD + (w.lane & 15) * 8;
    int nb = __builtin_ctz(bm), jj = 0;
    bf16x8 kf[8]; u32x4 vr[8];
    { load_kt(kb + ((size_t)(nb * 8) << 12), kf); load_vp(vb + (size_t)(nb * 256) * NQKV, NQKV, vr); }
#pragma unroll 1
    for (;;) {
        const f32x16 acc = qk_mma(kf, qf);
        int nb2 = nb, jj2 = jj + 1; unsigned bm2 = bm;
        if (jj2 > (nb == own ? jd : 7)) { bm2 &= bm2 - 1u; jj2 = 0; nb2 = bm2 ? __builtin_ctz(bm2) : 0; }
        const bool more = bm2 != 0u;
        const size_t ko2 = (size_t)(nb2 * 256 + 32 * jj2) * NQKV;
        if (more) load_kt(kb + ((size_t)(nb2 * 8 + jj2) << 12), kf);
        const int key0 = nb * 256 + 32 * jj, dq = t0 - key0 + w.q - 4 * w.h;
        const bool rowsel = (nb == own) || ((sel >> nb) & 1u);
        float s[16];
        const int dlt = t0 - key0;
        bool uni = false;
        if (dlt >= 31) uni = __builtin_amdgcn_readfirstlane((int)bkt[dlt - 31]) == __builtin_amdgcn_readfirstlane((int)bkt[dlt + 31]);
        if (uni) {
            const float bu = btab[dlt], lim = rowsel ? INFINITY : -INFINITY;
#pragma unroll
            for (int i = 0; i < 16; ++i) s[i] = fminf(acc[i] * SC2 + bu, lim);
        } else {
#pragma unroll
            for (int i = 0; i < 16; ++i) { const int dist = dq - (8 * (i >> 2) + (i & 3)); const bool valid = rowsel && dist >= 0; const float v = acc[i] * SC2 + btab[max(dist, 0)]; s[i] = fminf(v, valid ? INFINITY : -INFINITY); }
        }
        bf16x8 pf[2]; softmax_step(s, m, l, o, pf);
        stage_v(w, vr);
        pv_tile(w, pf, o);
        if (!more) break;
        load_vp(vb + ko2, NQKV, vr);
        nb = nb2; jj = jj2; bm = bm2;
    }
    const float lt = xh_sum(l), inv = 1.0f / lt;
    write_o(o, inv, O + tokq * D + head * HD, w.h);
}

__device__ __forceinline__ void moba_logits(const f32x16& acc, int t0, int key0, bool rowsel, const LAS float* btab, const LAS unsigned char* bkt, const WCtx& w, float (&s)[16]) {
    const int dlt = t0 - key0, dq = dlt + w.q - 4 * w.h;
    bool uni = false;
    if (dlt >= 31) uni = __builtin_amdgcn_readfirstlane((int)bkt[dlt - 31]) == __builtin_amdgcn_readfirstlane((int)bkt[dlt + 31]);
    if (uni) {
        const float bu = btab[dlt], lim = rowsel ? INFINITY : -INFINITY;
#pragma unroll
        for (int i = 0; i < 16; ++i) s[i] = fminf(acc[i] * SC2 + bu, lim);
    } else {
        float bv[16];
#pragma unroll
        for (int i = 0; i < 16; ++i) bv[i] = btab[max(dq - (8 * (i >> 2) + (i & 3)), 0)];
        PIN16(bv);
#pragma unroll
        for (int i = 0; i < 16; ++i) { const int dist = dq - (8 * (i >> 2) + (i & 3)); const bool valid = rowsel && dist >= 0; s[i] = fminf(acc[i] * SC2 + bv[i], valid ? INFINITY : -INFINITY); }
    }
}
__device__ __forceinline__ void softmax_step2(const float (&sa)[16], const float (&sb)[16], float& m, float& l, f32x16 (&o)[4], bf16x8 (&pfa)[2], bf16x8 (&pfb)[2]) {
    float mx = fmaxf(sa[0], sb[0]);
#pragma unroll
    for (int i = 1; i < 16; ++i) mx = fmaxf(mx, fmaxf(sa[i], sb[i]));
    mx = xh_max(mx);
    const float mn = fmaxf(m, mx), mu = (mn == -INFINITY) ? 0.f : mn;
    const float alpha = __builtin_amdgcn_exp2f(m - mu);
    float pa[16], pb[16], ps = 0.f;
#pragma unroll
    for (int i = 0; i < 16; ++i) { pa[i] = __builtin_amdgcn_exp2f(sa[i] - mu); pb[i] = __builtin_amdgcn_exp2f(sb[i] - mu); ps += pa[i] + pb[i]; }
    l = l * alpha + ps; m = mn;
    if (__builtin_amdgcn_ballot_w64(alpha != 1.0f) != 0ull) {
#pragma unroll
        for (int c = 0; c < 4; ++c)
#pragma unroll
            for (int i = 0; i < 16; ++i) o[c][i] *= alpha; }
    pack_p(pa, pfa); pack_p(pb, pfb);
}

__device__ __forceinline__ void moba_wg(const bf16* qkv, const bf16* KT, const float* kmq, int b, int hh, int own, int wave, int tid, bf16* O, const LAS float* btab, const LAS unsigned char* bkt, LAS unsigned char* lds, const WCtx& w) {
    const int head = 8 + hh, t0 = own * 256 + wave * 32;
    const size_t tokq = (size_t)b * SEQ + t0 + w.q;
    bf16x8 qf[8]; load_q(qkv + tokq * NQKV + head * HD + 8 * w.h, qf);
    unsigned sel = (1u << own) - 1u;
    if (own > 3) {
        const int n = w.q & 15; const size_t ko = ((size_t)(b * 8 + hh) * 16 + n) * HD + 8 * w.h; constexpr size_t QS = (size_t)BATCH * 8 * 16 * HD;
        f32x16 g;
#pragma unroll
        for (int i = 0; i < 16; ++i) g[i] = 0.f;
#pragma unroll
        for (int s = 0; s < 8; ++s) {
            f32x4 a0 = *(const f32x4*)(kmq + ko + 16 * s), a1 = *(const f32x4*)(kmq + ko + 16 * s + 4);
#pragma unroll
            for (int qd = 1; qd < 4; ++qd) { a0 += *(const f32x4*)(kmq + qd * QS + ko + 16 * s); a1 += *(const f32x4*)(kmq + qd * QS + ko + 16 * s + 4); }
            a0 *= (1.0f / 256.0f); a1 *= (1.0f / 256.0f);
            u32x4 hi; hi.x = cvtpk(a0[0], a0[1]); hi.y = cvtpk(a0[2], a0[3]); hi.z = cvtpk(a1[0], a1[1]); hi.w = cvtpk(a1[2], a1[3]);
            u32x4 lo; lo.x = cvtpk(a0[0] - __uint_as_float(hi.x << 16), a0[1] - __uint_as_float(hi.x & 0xffff0000u)); lo.y = cvtpk(a0[2] - __uint_as_float(hi.y << 16), a0[3] - __uint_as_float(hi.y & 0xffff0000u));
            lo.z = cvtpk(a1[0] - __uint_as_float(hi.z << 16), a1[1] - __uint_as_float(hi.z & 0xffff0000u)); lo.w = cvtpk(a1[2] - __uint_as_float(hi.w << 16), a1[3] - __uint_as_float(hi.w & 0xffff0000u));
            g = MFMA32(__builtin_bit_cast(bf16x8, hi), qf[s], g); g = MFMA32(__builtin_bit_cast(bf16x8, lo), qf[s], g); }
        float pg[8], gv[16];
#pragma unroll
        for (int i = 0; i < 8; ++i) pg[i] = xh_other(g[i], w.h);
#pragma unroll
        for (int nn = 0; nn < 16; ++nn) { const int a = nn >> 3, bb = (nn >> 2) & 1, e = nn & 3; const float v = (bb == w.h) ? g[4 * a + e] : pg[4 * a + e]; gv[nn] = (nn < own) ? v : -INFINITY; }
        sel = 0u;
#pragma unroll
        for (int rd = 0; rd < 3; ++rd) { float best = -INFINITY; int bi = 0;
#pragma unroll
            for (int nn = 0; nn < 16; ++nn) { const bool take = !((sel >> nn) & 1u) && (gv[nn] > best); best = take ? gv[nn] : best; bi = take ? nn : bi; }
            sel |= 1u << bi; }
    }
    unsigned bmw = 1u << own;
#pragma unroll
    for (int n = 0; n < 15; ++n) if (__builtin_amdgcn_ballot_w64((sel >> n) & 1u) != 0ull) bmw |= 1u << n;
    LAS unsigned* wgw = (LAS unsigned*)(lds + 86016);
    if (tid == 0) wgw[0] = 0u;
    __syncthreads();
    if (w.lane == 0) __hip_atomic_fetch_or(wgw, bmw, __ATOMIC_RELAXED, __HIP_MEMORY_SCOPE_WORKGROUP);
    __syncthreads();
    unsigned bm = (unsigned)__builtin_amdgcn_readfirstlane((int)wgw[0]);
    f32x16 o[4]; ZERO_O(o); float m = -INFINITY, l = 0.f;
    const bf16* kg = KT + ((size_t)((b * 16 + head) * 128) << 12) + tid * 8;
    const bf16* vg = qkv + ((size_t)b * SEQ + (tid >> 4)) * NQKV + 2 * D + head * HD + (tid & 15) * 8;
    const unsigned kst = (unsigned)tid * 16u;
    unsigned vst; { const int kr = w.lane >> 4, ch = w.lane & 15, x = ((wave >> 1) & 1) + 2 * (wave & 1);
        vst = (unsigned)(8192 + 2048 * ((wave & 1) + 2 * (wave >> 2)) + 256 * ((wave >> 1) & 1) + 512 * (ch >> 2) + 64 * kr + 16 * ((ch & 3) ^ x)); }
    int nb = __builtin_ctz(bm), u = 0, buf = 0;
    u32x4 kra, vra, krb, vrb;
    { const size_t t = (size_t)(nb * 8); const size_t k0 = (size_t)(nb * 256) * NQKV;
      kra = *(const u32x4*)(kg + (t << 12)); krb = *(const u32x4*)(kg + ((t + 1) << 12)); vra = *(const u32x4*)(vg + k0); vrb = *(const u32x4*)(vg + k0 + (size_t)32 * NQKV); }
    *(LAS u32x4*)(lds + kst) = kra; *(LAS u32x4*)(lds + vst) = vra; *(LAS u32x4*)(lds + 16384 + kst) = krb; *(LAS u32x4*)(lds + 16384 + vst) = vrb;
    __syncthreads();
#pragma unroll 1
    for (;;) {
        int nb2 = nb, u2 = u + 1; unsigned bm2 = bm;
        if (u2 > 3) { bm2 &= bm2 - 1u; u2 = 0; nb2 = bm2 ? __builtin_ctz(bm2) : 0; }
        const bool more = bm2 != 0u;
        if (more) { const size_t t = (size_t)(nb2 * 8 + 2 * u2); const size_t k0 = (size_t)(nb2 * 256 + 64 * u2) * NQKV;
            kra = *(const u32x4*)(kg + (t << 12)); krb = *(const u32x4*)(kg + ((t + 1) << 12)); vra = *(const u32x4*)(vg + k0); vrb = *(const u32x4*)(vg + k0 + (size_t)32 * NQKV); }
        const bool mine = ((bmw >> nb) & 1u) && (nb != own || 2 * u <= wave);
        if (mine) {
            const LAS unsigned char* base = lds + buf * 32768;
            const LAS unsigned char* kimg = base + w.lane * 16;
            bf16x8 kfa[8], kfb[8];
#pragma unroll
            for (int s = 0; s < 8; ++s) { kfa[s] = *(const LAS bf16x8*)(kimg + 1024 * s); kfb[s] = *(const LAS bf16x8*)(kimg + 16384 + 1024 * s); }
            f32x16 acca, accb;
#pragma unroll
            for (int i = 0; i < 16; ++i) { acca[i] = 0.f; accb[i] = 0.f; }
#pragma unroll
            for (int s = 0; s < 8; ++s) { acca = MFMA32(kfa[s], qf[s], acca); accb = MFMA32(kfb[s], qf[s], accb); }
            const int key0 = nb * 256 + 64 * u;
            const bool rowsel = (nb == own) || ((sel >> nb) & 1u);
            float sa[16], sb[16];
            moba_logits(acca, t0, key0, rowsel, btab, bkt, w, sa);
            moba_logits(accb, t0, key0 + 32, rowsel, btab, bkt, w, sb);
            bf16x8 pfa[2], pfb[2]; softmax_step2(sa, sb, m, l, o, pfa, pfb);
            pv_tile_b(base + 8192, w, pfa, o);
            pv_tile_b(base + 16384 + 8192, w, pfb, o);
        }
        if (more) { LAS unsigned char* nb_ = lds + (buf ^ 1) * 32768;
            *(LAS u32x4*)(nb_ + kst) = kra; *(LAS u32x4*)(nb_ + vst) = vra; *(LAS u32x4*)(nb_ + 16384 + kst) = krb; *(LAS u32x4*)(nb_ + 16384 + vst) = vrb; }
        __syncthreads();
        if (!more) break;
        nb = nb2; u = u2; bm = bm2; buf ^= 1;
    }
    const float lt = xh_sum(l), inv = 1.0f / lt;
    write_o(o, inv, O + tokq * D + head * HD, w.h);
}

__device__ __forceinline__ void sb_wave(const bf16* qkv, const bf16* KT, int b, int head, int t0, bf16* O, const WCtx& w) {
    const size_t tokq = (size_t)b * SEQ + t0 + w.q;
    bf16x8 qf[8]; load_q(qkv + tokq * NQKV + head * HD + 8 * w.h, qf);
    f32x16 o[4]; ZERO_O(o); float carry = 0.f;
    const bf16* kp = KT + ((size_t)((b * 16 + head) * 128 + (t0 >> 5)) << 12) + w.lane * 8;
    const bf16* vp = qkv + ((size_t)b * SEQ + t0 + (w.lane >> 4)) * NQKV + 2 * D + head * HD + (w.lane & 15) * 8;
    bf16x8 kf[8]; u32x4 vr[8]; load_kt(kp, kf); load_vp(vp, NQKV, vr);
    int kt = t0 >> 5; const int ktd = kt;
#pragma unroll 1
    for (;;) {
        const f32x16 acc = qk_mma(kf, qf);
        const bool diag = (kt == ktd), notlast = kt > 0;
        if (notlast) { kp -= 4096; load_kt(kp, kf); }
        float lk[16], ls[16];
#pragma unroll
        for (int i = 0; i < 16; ++i) { const int kk = 8 * (i >> 2) + 4 * w.h + (i & 3); const bool past = !diag || (kk < w.q);
            const float z = acc[i] * SC2, az = fabsf(z), e = __builtin_amdgcn_exp2f(-az), L = __builtin_amdgcn_logf(1.0f + e);
            lk[i] = past ? -(fmaxf(z, 0.f) + L) : 0.f; ls[i] = past ? (fminf(z, 0.f) - L) : -INFINITY; }
        float sg[4], pg[4];
#pragma unroll
        for (int g = 0; g < 4; ++g) { sg[g] = (lk[4 * g] + lk[4 * g + 1]) + (lk[4 * g + 2] + lk[4 * g + 3]); pg[g] = xh_other(sg[g], w.h); }
        float run = 0.f, p[16];
#pragma unroll
        for (int g = 3; g >= 0; --g) {
            float bt = carry + run + (w.h == 0 ? pg[g] : 0.f);
#pragma unroll
            for (int e = 3; e >= 0; --e) { p[4 * g + e] = __builtin_amdgcn_exp2f(ls[4 * g + e] + bt); bt += lk[4 * g + e]; }
            run += sg[g] + pg[g]; }
        carry += run;
        bf16x8 pf[2]; pack_p(p, pf);
        const bool more = notlast && (__builtin_amdgcn_ballot_w64(carry >= -170.0f) != 0ull);
        stage_v(w, vr);
        pv_tile(w, pf, o);
        if (!more) break;
        vp -= (size_t)32 * NQKV; load_vp(vp, NQKV, vr);
        --kt;
    }
    write_o(o, 1.0f, O + tokq * D + head * HD, w.h);
}

__device__ __forceinline__ void kmean_wave(const bf16* KT, float* kmq, int wt, int lane) {
    const int qd = wt & 3, n = (wt >> 2) & 15, hh = (wt >> 6) & 7, b = wt >> 9;
    const bf16* kp = KT + ((size_t)((b * 16 + 8 + hh) * 128 + n * 8 + qd * 2) << 12) + (lane >> 3) * 512 + ((lane >> 2) & 1) * 256 + 2 * (lane & 3);
    float s0 = 0.f, s1 = 0.f;
#pragma unroll 16
    for (int j = 0; j < 64; ++j) { const unsigned v = *(const unsigned*)(kp + (size_t)(j >> 5) * 4096 + (j & 31) * 8); s0 += __uint_as_float(v << 16); s1 += __uint_as_float(v & 0xffff0000u); }
    float* o = kmq + (size_t)qd * BATCH * 8 * 16 * HD + ((size_t)(b * 8 + hh) * 16 + n) * HD + 2 * lane;
    o[0] = s0; o[1] = s1;
}
__device__ __forceinline__ void combine_wave(bf16* O, const bf16* br1, const bf16* br2, const float* lse, int tok, int lane) {
    const int head = lane >> 3, d0 = (lane & 7) * 16;
    const float l0 = lse[(size_t)tok * 8 + head], l1 = lse[(size_t)M * 8 + (size_t)tok * 8 + head], l2 = lse[(size_t)2 * M * 8 + (size_t)tok * 8 + head];
    const float mx = fmaxf(l0, fmaxf(l1, l2)); float a0 = __builtin_amdgcn_exp2f(l0 - mx), a1 = __builtin_amdgcn_exp2f(l1 - mx), a2 = __builtin_amdgcn_exp2f(l2 - mx);
    const float inv = 1.0f / (a0 + a1 + a2); a0 *= inv; a1 *= inv; a2 *= inv;
    bf16* po = O + (size_t)tok * D + head * HD + d0; const bf16* p1 = br1 + (size_t)tok * 1024 + head * HD + d0; const bf16* p2 = br2 + (size_t)tok * 1024 + head * HD + d0;
#pragma unroll
    for (int k = 0; k < 2; ++k) {
        const u32x4 x0 = *(const u32x4*)(po + 8 * k), x1 = *(const u32x4*)(p1 + 8 * k), x2 = *(const u32x4*)(p2 + 8 * k); u32x4 y;
#pragma unroll
        for (int e = 0; e < 4; ++e) {
            const float lo = a0 * __uint_as_float(x0[e] << 16) + a1 * __uint_as_float(x1[e] << 16) + a2 * __uint_as_float(x2[e] << 16);
            const float hi = a0 * __uint_as_float(x0[e] & 0xffff0000u) + a1 * __uint_as_float(x1[e] & 0xffff0000u) + a2 * __uint_as_float(x2[e] & 0xffff0000u);
            y[e] = cvtpk(lo, hi); }
        *(u32x4*)(po + 8 * k) = y; }
}

template <class T> __device__ __forceinline__ T* opaque(T* p) {
    unsigned lo = __builtin_amdgcn_readfirstlane((unsigned)(unsigned long long)p), hi = __builtin_amdgcn_readfirstlane((unsigned)((unsigned long long)p >> 32));
    asm volatile("" : "+s"(lo), "+s"(hi)); return (T*)(__attribute__((address_space(1))) T*)(((unsigned long long)hi << 32) | lo); }
__device__ __forceinline__ int opaque_v(int v) { asm volatile("" : "+v"(v)); return v; }

#define RLX_AGENT __ATOMIC_RELAXED, __HIP_MEMORY_SCOPE_AGENT
#define XB_TMO      128
#define XB_XCNT(j)  (256  + 64 * (j))
#define XB_XSUB(j)  (1280 + 64 * (j))
#define XB_XGEN(j)  (2304 + 64 * (j))
#define XB_TOP      3328
#define XB_TOPGEN   3392
#define XCD_BAR_WORDS 3456
#define XB_SPIN_CAP (1u << 18)

__device__ __forceinline__ unsigned xb_ld(unsigned* p)              { return __hip_atomic_load(p, __ATOMIC_RELAXED, __HIP_MEMORY_SCOPE_AGENT); }
__device__ __forceinline__ unsigned xb_add(unsigned* p, unsigned v) { return __hip_atomic_fetch_add(p, v, __ATOMIC_RELAXED, __HIP_MEMORY_SCOPE_AGENT); }
__device__ __forceinline__ unsigned xb_xcc_id() { return (unsigned)__builtin_amdgcn_s_getreg((3 << 11) | 20) & 0xFu; }
#define XB_SPIN(cond, bar) do { unsigned _sp = 0; while (cond) { __builtin_amdgcn_s_sleep(1); \
    if ((++_sp & 255u) == 0u) { if (xb_ld(&(bar)[XB_TMO])) break; if (_sp > XB_SPIN_CAP) { atomicAdd(&(bar)[XB_TMO], 1u); break; } } } } while (0)

struct XcdBarrier {
    int wv;
    unsigned* bar; unsigned x;
    volatile LAS unsigned* st;
};

__device__ __forceinline__ XcdBarrier xcd_barrier_post(unsigned* bar, volatile LAS unsigned* st) {
    XcdBarrier b; b.wv = __builtin_amdgcn_readfirstlane((int)(threadIdx.x >> 6)); b.bar = bar; b.x = xb_xcc_id(); b.st = st;
    if (threadIdx.x == 0) (void)xb_add(&bar[XB_XCNT(b.x)], 1u);
    return b;
}
__device__ __forceinline__ void xcd_barrier_complete(unsigned* bar, unsigned x, unsigned& nloc, unsigned& nx) {
    const unsigned G = gridDim.x * gridDim.y * gridDim.z;
    unsigned sum, cnt, mine, sp = 0u;
    for (;;) {
        sum = 0u; cnt = 0u; mine = 0u;
#pragma unroll
        for (unsigned j = 0; j < 16; ++j) { const unsigned c = xb_ld(&bar[XB_XCNT(j)]); sum += c; cnt += (c > 0u) ? 1u : 0u; mine = (j == x) ? c : mine; }
        if (sum == G) break;
        __builtin_amdgcn_s_sleep(1);
        if ((++sp & 255u) == 0u) { if (xb_ld(&bar[XB_TMO])) break; if (sp > XB_SPIN_CAP) { atomicAdd(&bar[XB_TMO], 1u); break; } }
    }
    nloc = mine > 0u ? mine : 1u; nx = cnt > 0u ? cnt : 1u;
}

__device__ __forceinline__ void xcd_barrier(const XcdBarrier& b) {
    asm volatile("s_waitcnt vmcnt(0)" ::: "memory");
    __syncthreads();
    if (b.wv == 0 && pg8::lane_id() == 0) {
        unsigned* bar = b.bar;
        __builtin_amdgcn_s_waitcnt(0);
        unsigned nloc = b.st[0], nx = b.st[1];
        if (nloc == 0u) { xcd_barrier_complete(bar, b.x, nloc, nx); b.st[0] = nloc; b.st[1] = nx; }
        const unsigned old = xb_add(&bar[XB_XSUB(b.x)], 1u);
        const unsigned gen = old / nloc;
        if (old + 1u == (gen + 1u) * nloc) {
            __builtin_amdgcn_fence(__ATOMIC_RELEASE, "agent");
            asm volatile("s_waitcnt vmcnt(0)" ::: "memory");
            const unsigned og = xb_add(&bar[XB_TOP], 1u);
            const unsigned tg = og / nx;
            if (og + 1u == (tg + 1u) * nx) xb_add(&bar[XB_TOPGEN], 1u);
            else XB_SPIN(xb_ld(&bar[XB_TOPGEN]) == tg, bar);
            __builtin_amdgcn_fence(__ATOMIC_ACQUIRE, "agent");
            xb_add(&bar[XB_XGEN(b.x)], 1u);
            asm volatile("s_waitcnt vmcnt(0)" ::: "memory");
        } else {
            XB_SPIN(xb_ld(&bar[XB_XGEN(b.x)]) == gen, bar);
            __builtin_amdgcn_fence(__ATOMIC_ACQUIRE, "agent");
            asm volatile("s_waitcnt vmcnt(0)" ::: "memory");
        }
    }
    __syncthreads();
}


#define TIDX (wave_s * 64 + pg8::lane_id())
#ifndef REP_BAR
#define REP_BAR 1
#endif
#define STAMP() do { } while (0)
#define GRID_BAR() do { for (int rb_ = 0; rb_ < REP_BAR; ++rb_) xcd_barrier(bar); STAMP(); } while (0)
template <int s>
__device__ __forceinline__ void fwd_step(const Args& args, LAS unsigned char* lds, const XcdBarrier& bar, const int wave_s, const int cidx  ) {
        const int layer = s / 3, k3 = s - 3 * layer;
        if (k3 != 1) {
            const int widx = layer * 2 + (k3 >> 1);
            {
                unsigned char* ws = opaque(args.ws); const int G = gridDim.x, bx = blockIdx.x;
                pg8::Gemm g{(const bf16*)(ws + WS_U), (const bf16*)(ws + WS_W1 + widx * SZ_W1), M, 2 * FF, D}; pg8::StaticOrder S; S.init(M, 2 * FF, G, cidx);
                const float* ssp = (const float*)(ws + WS_SS) + (size_t)s * M * 32; LAS float* rt = (LAS float*)(lds + 155712);
                pg8::Unit u0; S.next(0, u0);
                { const int t_ = TIDX; if (t_ < 256) { const f32x4* pp = (const f32x4*)(ssp + (size_t)(u0.pm * 256 + t_) * 32); f32x4 a = pp[0];
#pragma unroll
                    for (int k = 1; k < 8; ++k) a += pp[k];
                    rt[t_] = __builtin_amdgcn_rsqf(((a.x + a.y) + (a.z + a.w)) * (1.0f / 2048.0f) + 1e-6f); } }
                __syncthreads();
                pg8::EpiSwiglu E{(bf16*)(ws + WS_BIG), FF, ssp, u0.pm};
                for (int rep = 0; rep < REP_GEMM; ++rep) { if (rep > 0) GRID_BAR(); pg8::gemm_phase<pg8::EpiSwiglu, pg8::StaticOrder, true, true>(lds, g, S, E, wave_s); }
            }
            GRID_BAR();
            {
                unsigned char* ws = opaque(args.ws); const int G = gridDim.x, bx = blockIdx.x; float* out = opaque(args.out);
                pg8::Gemm g{(const bf16*)(ws + WS_BIG), (const bf16*)(ws + WS_W2 + widx * SZ_W2), M, D, FF}; pg8::StaticOrder S; S.init(M, D, G, cidx);
                pg8::EpiResid E{(bf16*)(ws + WS_U), (float*)(ws + WS_SS) + (size_t)(s + 1) * M * 32, D, 0.5f};
                pg8::gemm_phase<pg8::EpiResid, pg8::StaticOrder, true, true>(lds, g, S, E, wave_s);
            }
            GRID_BAR();
        } else {
            {
                unsigned char* ws = opaque(args.ws); const int G = gridDim.x, bx = blockIdx.x;
                pg8::Gemm g{(const bf16*)(ws + WS_U), (const bf16*)(ws + WS_WQKV + layer * SZ_WQKV), M, NQKV, D}; pg8::StaticOrder S; S.init(M, NQKV, G, cidx);
                const float* ssp = (const float*)(ws + WS_SS) + (size_t)s * M * 32; LAS float* rt = (LAS float*)(lds + 155712);
                pg8::Unit u0; S.next(0, u0);
                { const int t_ = TIDX; if (t_ < 256) { const f32x4* pp = (const f32x4*)(ssp + (size_t)(u0.pm * 256 + t_) * 32); f32x4 a = pp[0];
#pragma unroll
                    for (int k = 1; k < 8; ++k) a += pp[k];
                    rt[t_] = __builtin_amdgcn_rsqf(((a.x + a.y) + (a.z + a.w)) * (1.0f / 2048.0f) + 1e-6f); } }
                __syncthreads();
                pg8::EpiQkv E{(bf16*)(ws + WS_BIG), NQKV, ssp, u0.pm, (bf16*)(ws + WS_KT), layer == 0 ? 12 : 8};
                for (int rep = 0; rep < REP_GEMM; ++rep) { if (rep > 0) GRID_BAR(); pg8::gemm_phase<pg8::EpiQkv, pg8::StaticOrder, true, true>(lds, g, S, E, wave_s); }
            }
            GRID_BAR();
            if (layer == 0) {
                {
                    unsigned char* ws = opaque(args.ws); const int G = gridDim.x, bx = blockIdx.x;
                    const int tid = opaque_v(TIDX), lane = tid & 63, wave = __builtin_amdgcn_readfirstlane(tid >> 6);
                    const bf16* BIG = (const bf16*)(ws + WS_BIG); bf16* OB = (bf16*)(ws + WS_O); bf16* BR1 = (bf16*)opaque(args.out); bf16* BR2 = BR1 + (size_t)M * 1024;
                    float* LSE = (float*)(ws + WS_LSE); const float* BIAS = (const float*)(ws + WS_BIAS);
                    LAS float* btab = (LAS float*)(lds + 133120);
                    WCtx w; wctx_init(w, lds + wave * 8192, lane);
                    int cur_head = -1;
                    for (int rep = 0; rep < REP_DIL; ++rep)
                    for (int task = bx; task < 1536; task += G) {
                        {
                            const int ri = task >> 9, rem = task & 511, b = rem >> 7, head = (rem >> 4) & 7, grp = rem & 15;
                            const int r = ri == 0 ? 1 : (ri == 1 ? 4 : 16), sh = ri == 0 ? 7 : (ri == 1 ? 5 : 3), wt = grp * 8 + wave, c = wt >> sh, l0 = (wt - (c << sh)) * 32;
                            if (head != cur_head) {
                                __syncthreads();
                                for (int i = tid; i < 2112; i += NTHR) btab[i] = BIAS[head * 4096 + i];
                                __syncthreads();
                                cur_head = head; }
                            bf16* ob = ri == 0 ? OB : (ri == 1 ? BR1 : BR2);
                            dilated_wave(BIG, b, head, r, c, l0, ob, ri == 0 ? D : 1024, LSE + (size_t)ri * M * 8, btab, lds + 65536 + wave * 8448, w);
                        }
                    }
                    for (int wt = bx * NWAVES + wave; wt < 2048; wt += G * NWAVES) kmean_wave((const bf16*)(ws + WS_KT), (float*)(ws + WS_KMH), wt, lane);
                }
                GRID_BAR();
                {
                    unsigned char* ws = opaque(args.ws); const int G = gridDim.x, bx = blockIdx.x;
                    const int tid = opaque_v(TIDX), lane = tid & 63, wave = __builtin_amdgcn_readfirstlane(tid >> 6);
                    const bf16* BIG = (const bf16*)(ws + WS_BIG); bf16* OB = (bf16*)(ws + WS_O); bf16* BR1 = (bf16*)opaque(args.out); bf16* BR2 = BR1 + (size_t)M * 1024;
                    const float* BIAS = (const float*)(ws + WS_BIAS);
                    LAS float* btab = (LAS float*)(lds + 65536);
                    WCtx w; wctx_init(w, lds + wave * 8192, lane);
                    int cur_hh = -1;
                    for (int rep = 0; rep < REP_MOBA; ++rep)
                    for (int task = bx; task < 512; task += G) {
                        const int tt = task & 255, b = tt >> 6, hh = (tt >> 3) & 7, xx = tt & 7, own = task < 256 ? xx : 15 - xx;
                        if (hh != cur_hh) {
                            __syncthreads();
                            for (int i = tid; i < 4096; i += NTHR) btab[i] = BIAS[(8 + hh) * 4096 + i];
                            for (int i = tid; i < 1024; i += NTHR) ((LAS unsigned*)(lds + 81920))[i] = ((const unsigned*)(ws + WS_BKT))[i];
                            __syncthreads();
                            cur_hh = hh; }
                        moba_wg(BIG, (const bf16*)(ws + WS_KT), (const float*)(ws + WS_KMH), b, hh, own, wave, tid, OB, btab, (const LAS unsigned char*)(lds + 81920), lds, w);
                    }
                    const int gw = bx * NWAVES + wave, NGW = G * NWAVES;
                    for (int tok = gw; tok < M; tok += NGW) combine_wave(OB, BR1, BR2, (const float*)(ws + WS_LSE), tok, lane);
                }
                GRID_BAR();
            } else {
                {
                    unsigned char* ws = opaque(args.ws); const int G = gridDim.x, bx = blockIdx.x;
                    const int tid = opaque_v(TIDX), lane = tid & 63, wave = __builtin_amdgcn_readfirstlane(tid >> 6);
                    WCtx w; wctx_init(w, lds + wave * 8192, lane);
                    for (int rep = 0; rep < REP_SB; ++rep)
                    for (int task = bx; task < 1024; task += G) {
                        const int b = task >> 8, head = (task >> 4) & 15, qb = task & 15;
                        sb_wave((const bf16*)(ws + WS_BIG), (const bf16*)(ws + WS_KT), b, head, qb * 256 + wave * 32, (bf16*)(ws + WS_O), w);
                    }
                }
                GRID_BAR();
            }
            {
                unsigned char* ws = opaque(args.ws); const int G = gridDim.x, bx = blockIdx.x; float* out = opaque(args.out);
                pg8::Gemm g{(const bf16*)(ws + WS_O), (const bf16*)(ws + WS_WO + layer * SZ_WO), M, D, D}; pg8::StaticOrder S; S.init(M, D, G, cidx);
                pg8::EpiResid E{(bf16*)(ws + WS_U), (float*)(ws + WS_SS) + (size_t)(s + 1) * M * 32, D, 1.0f};
                pg8::gemm_phase<pg8::EpiResid, pg8::StaticOrder, true, true>(lds, g, S, E, wave_s);
            }
            GRID_BAR();
        }
}

__global__ void __launch_bounds__(NTHR, 2) fwd_megakernel(Args args) {
    cg::grid_group grid = cg::this_grid();
    LAS unsigned char* lds = (LAS unsigned char*)pg8::lds_raw;
    volatile LAS unsigned* bst = (volatile LAS unsigned*)(lds + 155648);
    if (threadIdx.x < 2) bst[threadIdx.x] = 0u;
    __syncthreads();
    const XcdBarrier bar = xcd_barrier_post((unsigned*)(args.ws + WS_CTL), bst);
    const int wave_s = bar.wv;
    unsigned* xcnt = (unsigned*)(args.ws + WS_CTL + 15360);
    if (TIDX == 0) bst[4] = __hip_atomic_fetch_add(xcnt + 16 * bar.x, 1u, __ATOMIC_RELAXED, __HIP_MEMORY_SCOPE_AGENT);

#ifndef REP_ALL
#define REP_ALL 1
#endif
    STAMP();
#pragma unroll 1
    for (int rep_all = 0; rep_all < REP_ALL; ++rep_all) {
    if (rep_all > 0) GRID_BAR();
    {
        const int tid = opaque_v(TIDX), lane = tid & 63, wave = __builtin_amdgcn_readfirstlane(tid >> 6);
        const int G = gridDim.x, bx = blockIdx.x, gw = bx * NWAVES + wave, NGW = G * NWAVES;
        for (int rep = 0; rep < REP_P0; ++rep)
        p0_weights(args, gw, NGW, lane);
        p0_bias(args, bx * NTHR + tid, G * NTHR);
        const float* x = as_global(args.in[0]); unsigned char* wsg = as_global(args.ws); bf16* HB = (bf16*)(wsg + WS_U); float* SS = (float*)(wsg + WS_SS);
        for (int mrow = gw; mrow < M; mrow += NGW) x_row(x + (size_t)mrow * D, HB + (size_t)mrow * D, SS + (size_t)mrow * 32, lane);
    }
    if (rep_all == 0) { grid.sync(); STAMP(); } else GRID_BAR();
    if (TIDX == 0) { bool even = (gridDim.x % 8u) == 0u;
        for (int j = 0; j < 8; ++j) even = even && (__hip_atomic_load(xcnt + 16 * j, __ATOMIC_RELAXED, __HIP_MEMORY_SCOPE_AGENT) == gridDim.x / 8u);
        bst[5] = (even && bar.x < 8u) ? (bst[4] * 8u + bar.x) : blockIdx.x; }
    __syncthreads();
    const int cidx = __builtin_amdgcn_readfirstlane((int)bst[5]);

    fwd_step<0>(args, lds, bar, wave_s, cidx); fwd_step<1>(args, lds, bar, wave_s, cidx); fwd_step<2>(args, lds, bar, wave_s, cidx);
    fwd_step<3>(args, lds, bar, wave_s, cidx); fwd_step<4>(args, lds, bar, wave_s, cidx); fwd_step<5>(args, lds, bar, wave_s, cidx);
    {
        unsigned char* ws = opaque(args.ws); float* out = opaque(args.out);
        const int tid = opaque_v(TIDX), lane = tid & 63, wave = __builtin_amdgcn_readfirstlane(tid >> 6);
        const int gw = blockIdx.x * NWAVES + wave, NGW = gridDim.x * NWAVES;
        const float* g = as_global(args.in[10]); const float* SS = (const float*)(ws + WS_SS) + (size_t)6 * M * 32;
        for (int mrow = gw; mrow < M; mrow += NGW) final_row(out + (size_t)mrow * D, (const bf16*)(ws + WS_U) + (size_t)mrow * D, g, SS + (size_t)mrow * 32, lane);
    }
    }
}

extern "C" void kernel_launch(void* const* d_in, const int* in_sizes, int n_in, void* d_out, int out_size, void* d_ws, size_t ws_size, hipStream_t stream) {
    static int grid = 0;
    if (grid == 0) {
        if (n_in != 11 || in_sizes[0] != M * D || out_size != M * D || ws_size < WS_END) {
            fprintf(stderr, "kernel_launch: shape/workspace mismatch (n_in %d, in0 %d, out %d, ws %zu, need %zu); nothing launched\n", n_in, n_in > 0 ? in_sizes[0] : -1, out_size, ws_size, (size_t)WS_END);
            grid = -1; return; }
        int dev = 0, cus = 0, per_cu = 0;
        (void)hipGetDevice(&dev); (void)hipDeviceGetAttribute(&cus, hipDeviceAttributeMultiprocessorCount, dev);
        if (hipFuncSetAttribute((const void*)fwd_megakernel, hipFuncAttributeMaxDynamicSharedMemorySize, LDS_BYTES) != hipSuccess) { fprintf(stderr, "kernel_launch: hipFuncSetAttribute failed\n"); grid = -1; return; }
        if (hipOccupancyMaxActiveBlocksPerMultiprocessor(&per_cu, (const void*)fwd_megakernel, NTHR, LDS_BYTES) != hipSuccess || per_cu < 1) { fprintf(stderr, "kernel_launch: occupancy query gave %d\n", per_cu); per_cu = 1; }
        (void)hipGetLastError();
        grid = cus * 1;
        if (grid > 256) grid = 256;
        if (grid != 256) { fprintf(stderr, "kernel_launch: built for a 256-CU MI355X (the GEMM epilogues rely on the 256-workgroup unit order); device has %d CUs; nothing launched\n", cus); grid = -1; return; }
    }
    if (grid < 0) return;
    if (hipMemsetAsync((char*)d_ws + WS_CTL, 0, CTL_BYTES, stream) != hipSuccess) { fprintf(stderr, "kernel_launch: memset of the barrier words failed\n"); return; }
    Args a{};
    for (int i = 0; i < 11; ++i) a.in[i] = (const float*)d_in[i];
    a.out = (float*)d_out; a.ws = (unsigned char*)d_ws;
    void* kargs[] = {&a};
    hipError_t e = hipLaunchCooperativeKernel((const void*)fwd_megakernel, dim3(grid), dim3(NTHR), kargs, LDS_BYTES, stream);
    if (e != hipSuccess) fprintf(stderr, "kernel_launch: cooperative launch failed: %s (grid %d)\n", hipGetErrorString(e), grid);
}
```
